# Optimizing an MI355X kernel written in HIP

```python
import math
import jax, jax.numpy as jnp
from jax import lax
import numpy as np

D_MODEL = 1024
BATCH = 4
SEQ = 4096
DEPTH = 2

CHUNK = 64
Q_BLOCK = 128
HEAD_DIM = 64
D_MIX = D_MODEL
D_FF = 4 * D_MODEL
EPS = 1e-6
ROPE_THETA = 500000.0
ROPE_DIM = HEAD_DIM // 4

A_HEADS = 4
A_QK_DIM = HEAD_DIM
A_V_DIM = 2 * HEAD_DIM
A_WIDTH = A_HEADS * A_V_DIM
B_HEADS = 4
B_LEFT_CHUNKS = 8
B_BAND = B_LEFT_CHUNKS + 1
REL_CLIP = 128
B_WIDTH = B_HEADS * HEAD_DIM
C_HEADS = 4
C_WIDTH = C_HEADS * HEAD_DIM

IN_SPLIT_SIZES = [A_HEADS * 2 * A_QK_DIM, A_HEADS * 2 * A_QK_DIM, A_WIDTH,
                  B_WIDTH, B_WIDTH, B_WIDTH,
                  C_WIDTH, C_WIDTH, C_WIDTH]
D_IN = sum(IN_SPLIT_SIZES)
IN_SPLITS = [int(v) for v in np.cumsum(IN_SPLIT_SIZES)[:-1]]

kernel_name = "hybrid_diff_chunkrel_stickbreak_block"


def rms_norm(x, g):
    xf = x.astype(jnp.float32)
    y = xf * lax.rsqrt(jnp.mean(xf * xf, axis=-1, keepdims=True) + EPS)
    return (y * g.astype(jnp.float32)).astype(x.dtype)


def head_rms_norm(o, g, n_heads):
    bsz, s, w = o.shape
    d = w // n_heads
    y = rms_norm(o.reshape(bsz, s, n_heads, d), g.reshape(n_heads, d))
    return y.reshape(bsz, s, w)


def rope_tables(seq):
    pos = jnp.arange(seq, dtype=jnp.float32)
    inv_freq = ROPE_THETA ** (-jnp.arange(0, ROPE_DIM, 2, dtype=jnp.float32) / ROPE_DIM)
    ang = pos[:, None] * inv_freq[None, :]
    return jnp.cos(ang), jnp.sin(ang)


def partial_rope(x, cos, sin):
    s = x.shape[1]
    shp = (1, s) + (1,) * (x.ndim - 3) + (ROPE_DIM // 2,)
    c = cos.reshape(shp).astype(x.dtype)
    sn = sin.reshape(shp).astype(x.dtype)
    x1 = x[..., : ROPE_DIM // 2]
    x2 = x[..., ROPE_DIM // 2: ROPE_DIM]
    rot = jnp.concatenate([x1 * c - x2 * sn, x2 * c + x1 * sn], axis=-1)
    return jnp.concatenate([rot, x[..., ROPE_DIM:]], axis=-1)


def diff_attention(q, k, v, lam, lam_init, subln_g):
    bsz, s = q.shape[0], q.shape[1]
    scale = A_QK_DIM ** -0.5
    pos = jnp.arange(s)
    outs = []
    for b0 in range(0, s, Q_BLOCK):
        e = b0 + Q_BLOCK
        sc = jnp.einsum('bqhnd,bkhnd->bhnqk', q[:, b0:e], k[:, :e]).astype(jnp.float32) * scale
        mask = (pos[:e][None, :] // CHUNK) <= (pos[b0:e][:, None] // CHUNK)
        sc = jnp.where(mask[None, None, None], sc, -jnp.inf)
        p = jax.nn.softmax(sc, axis=-1)
        w = p[:, :, 0] - lam * p[:, :, 1]
        outs.append(jnp.einsum('bhqk,bkhe->bqhe', w.astype(v.dtype), v[:, :e]))
    o = jnp.concatenate(outs, axis=1)
    o = rms_norm(o, subln_g) * (1.0 - lam_init)
    return o.reshape(bsz, s, A_WIDTH)


def chunk_rel_attention(q, k, v, rel_bias):
    bsz, s, h, d = q.shape
    nc = s // CHUNK
    qc = q.reshape(bsz, nc, CHUNK, h, d)
    pad = [(0, 0), (B_LEFT_CHUNKS * CHUNK, 0), (0, 0), (0, 0)]
    kp = jnp.pad(k, pad).reshape(bsz, nc + B_LEFT_CHUNKS, CHUNK, h, d)
    vp = jnp.pad(v, pad).reshape(bsz, nc + B_LEFT_CHUNKS, CHUNK, h, d)
    kband = jnp.concatenate([kp[:, j:j + nc] for j in range(B_BAND)], axis=2)
    vband = jnp.concatenate([vp[:, j:j + nc] for j in range(B_BAND)], axis=2)
    sc = jnp.einsum('bcqhd,bckhd->bchqk', qc, kband).astype(jnp.float32) * (d ** -0.5)
    qi = jnp.arange(CHUNK)
    kj = jnp.arange(B_BAND * CHUNK)
    rel = qi[:, None] + B_LEFT_CHUNKS * CHUNK - kj[None, :]
    idx = jnp.clip(rel, -REL_CLIP, REL_CLIP) + REL_CLIP
    bias = rel_bias[:, idx].astype(jnp.float32)
    ci = jnp.arange(nc)
    valid = (ci[:, None] - B_LEFT_CHUNKS + kj[None, :] // CHUNK) >= 0
    sc = jnp.where(valid[None, :, None, None, :], sc + bias[None, None], -jnp.inf)
    p = jax.nn.softmax(sc, axis=-1)
    o = jnp.einsum('bchqk,bckhd->bcqhd', p.astype(v.dtype), vband)
    return o.reshape(bsz, s, h * d)


def stick_breaking_attention(q, k, v):
    bsz, s, h, d = q.shape
    scale = d ** -0.5
    pos = jnp.arange(s)
    outs = []
    for b0 in range(0, s, Q_BLOCK):
        e = b0 + Q_BLOCK
        z = jnp.einsum('bqhd,bkhd->bhqk', q[:, b0:e], k[:, :e]).astype(jnp.float32) * scale
        causal = (pos[:e][None, :] < pos[b0:e][:, None])[None, None]
        log_beta = jax.nn.log_sigmoid(z)
        log_stay = jnp.where(causal, jax.nn.log_sigmoid(-z), 0.0)
        rem = lax.cumsum(log_stay, axis=3, reverse=True) - log_stay
        a = jnp.where(causal, jnp.exp(log_beta + rem), 0.0)
        outs.append(jnp.einsum('bhqk,bkhd->bqhd', a.astype(v.dtype), v[:, :e]))
    return jnp.concatenate(outs, axis=1).reshape(bsz, s, h * d)


def setup_inputs(seed: int = 0) -> dict:
    key = jax.random.key(seed)
    ks = jax.random.split(key, 20)
    f32 = jnp.float32
    nrm = lambda k, shp, sc: jax.random.normal(k, shp, f32) * sc
    gain = lambda k, n: 1.0 + 0.05 * jax.random.normal(k, (DEPTH, n), f32)
    return {
        "x": jax.random.normal(ks[0], (BATCH, SEQ, D_MODEL), f32),
        "norm_pre_mix": gain(ks[1], D_MODEL),
        "w_in": nrm(ks[2], (DEPTH, D_MODEL, D_IN), D_MODEL ** -0.5),
        "lam_q1": nrm(ks[3], (DEPTH, A_QK_DIM), 0.1),
        "lam_k1": nrm(ks[4], (DEPTH, A_QK_DIM), 0.1),
        "lam_q2": nrm(ks[5], (DEPTH, A_QK_DIM), 0.1),
        "lam_k2": nrm(ks[6], (DEPTH, A_QK_DIM), 0.1),
        "subln_a": gain(ks[7], A_V_DIM),
        "rel_bias": nrm(ks[8], (DEPTH, B_HEADS, 2 * REL_CLIP + 1), 0.2),
        "gn_b": gain(ks[9], B_WIDTH),
        "gn_c": gain(ks[10], C_WIDTH),
        "w_out": nrm(ks[11], (DEPTH, D_MIX, D_MODEL), D_MIX ** -0.5),
        "norm_post_mix": gain(ks[12], D_MODEL),
        "norm_pre_mlp": gain(ks[13], D_MODEL),
        "w_up": nrm(ks[14], (DEPTH, D_MODEL, D_FF), D_MODEL ** -0.5),
        "w_down": nrm(ks[15], (DEPTH, D_FF, D_MODEL), D_FF ** -0.5),
        "norm_post_mlp": gain(ks[16], D_MODEL),
    }


def reference(x, norm_pre_mix, w_in, lam_q1, lam_k1, lam_q2, lam_k2, subln_a, rel_bias,
              gn_b, gn_c, w_out, norm_post_mix, norm_pre_mlp, w_up, w_down, norm_post_mlp):
    bsz, s, _ = x.shape
    cos, sin = rope_tables(s)
    for l in range(DEPTH):
        h = rms_norm(x, norm_pre_mix[l])
        proj = h @ w_in[l]
        a_q, a_k, a_v, b_q, b_k, b_v, c_q, c_k, c_v = jnp.split(proj, IN_SPLITS, axis=-1)

        lam_init = 0.8 - 0.6 * math.exp(-0.3 * l)
        lam = (jnp.exp(jnp.sum(lam_q1[l].astype(jnp.float32) * lam_k1[l].astype(jnp.float32)))
               - jnp.exp(jnp.sum(lam_q2[l].astype(jnp.float32) * lam_k2[l].astype(jnp.float32)))
               + lam_init)
        qa = partial_rope(a_q.reshape(bsz, s, A_HEADS, 2, A_QK_DIM), cos, sin)
        ka = partial_rope(a_k.reshape(bsz, s, A_HEADS, 2, A_QK_DIM), cos, sin)
        va = a_v.reshape(bsz, s, A_HEADS, A_V_DIM)
        o_a = diff_attention(qa, ka, va, lam, lam_init, subln_a[l])

        o_b = chunk_rel_attention(b_q.reshape(bsz, s, B_HEADS, HEAD_DIM),
                                  b_k.reshape(bsz, s, B_HEADS, HEAD_DIM),
                                  b_v.reshape(bsz, s, B_HEADS, HEAD_DIM), rel_bias[l])
        o_b = head_rms_norm(o_b, gn_b[l], B_HEADS)

        o_c = stick_breaking_attention(c_q.reshape(bsz, s, C_HEADS, HEAD_DIM),
                                       c_k.reshape(bsz, s, C_HEADS, HEAD_DIM),
                                       c_v.reshape(bsz, s, C_HEADS, HEAD_DIM))
        o_c = head_rms_norm(o_c, gn_c[l], C_HEADS)

        y = jnp.concatenate([o_a, o_b, o_c], axis=-1) @ w_out[l]
        x = x + rms_norm(y, norm_post_mix[l])

        h = rms_norm(x, norm_pre_mlp[l])
        m = jnp.square(jax.nn.relu(h @ w_up[l])) @ w_down[l]
        x = x + rms_norm(m, norm_post_mlp[l])
    return x
```

```cpp
#include <hip/hip_runtime.h>
#include <hip/hip_cooperative_groups.h>
#include <cstdio>
#include <cstdint>
#include <cmath>
namespace cg = cooperative_groups;
#ifndef MK_SPLIT
#define MK_SPLIT 0
#endif

constexpr int SEQ = 4096, NBATCH = 4, DM = 1024, DFF = 4096, DIN = 3072, NTOK = NBATCH * SEQ, NLAYER = 2;
constexpr int QKP = 2048;
constexpr size_t VTB_OFF = (size_t)8 << 20, VTC_OFF = (size_t)12 << 20;
constexpr float RMS_EPS = 1e-6f;
constexpr float LOG2E = 1.4426950408889634f;
constexpr float QSCALE = 0.125f * LOG2E;

__device__ __forceinline__ int fresh_tid() { int t = threadIdx.x; asm volatile("" : "+v"(t)); return t; }

namespace pg8 {
#define PG8_LAS __attribute__((address_space(3)))
typedef unsigned short bf16_t;
typedef short bf16x8 __attribute__((ext_vector_type(8)));
typedef float f32x4 __attribute__((ext_vector_type(4)));
typedef unsigned u32x4 __attribute__((ext_vector_type(4)));
constexpr int BM = 256, BK = 64, HALF = 128, HTB = HALF * BK * 2  , STAGE_BYTES = 8 * HTB, NXCD = 8, WGM = 8;

__host__ __device__ __forceinline__ int lds_byte(int r, int c) { const int st = (r >> 4) * 2 + (c >> 5), rr = r & 15, cc = c & 31, ob = rr * 64 + cc * 2; return st * 1024 + (ob ^ (((ob >> 9) & 1) << 5)); }
__host__ __device__ __forceinline__ void stage_rc(int b, int& R, int& C) { const int st = b / 1024, sb = b % 1024, swz = sb ^ (((sb >> 9) & 1) << 5); R = (st >> 1) * 16 + swz / 64; C = (st & 1) * 32 + (swz % 64) / 2; }
__host__ __device__ __forceinline__ int perm32(int rho) { const int n = rho >> 4, i = rho & 15; return 8 * (i >> 2) + 4 * n + (i & 3); }

struct Unit { int pm, pn; };
struct Gemm { const bf16_t* A; const bf16_t* Bt; int M, N, K; };

struct StaticOrder {
    int nM, nN, nwg, G, c;
    __host__ __device__ void init(int M, int N, int G_, int c_) { nM = M / BM; nN = N / BM; nwg = nM * nN; G = G_; c = c_; }
    __host__ __device__ bool next(int i, Unit& u) const {
        const long L = (long)i * G + c; if (L >= nwg) return false;
        int wgid = (int)L; { const int q = nwg / NXCD, r = nwg % NXCD, xcd = wgid % NXCD, off = wgid / NXCD; wgid = (xcd < r ? xcd * (q + 1) : r * (q + 1) + (xcd - r) * q) + off; }
        const int nig = WGM * nN, gid = wgid / nig, fm = gid * WGM, gsz = (nM - fm) < WGM ? (nM - fm) : WGM;
        u.pm = fm + ((wgid % nig) % gsz); u.pn = (wgid % nig) / gsz; return true;
    }
    __device__ __forceinline__ void a_ready(const Unit&) const {}
    __device__ __forceinline__ void done(const Unit&) const {}
};

__device__ __forceinline__ unsigned cvt_pk_bf16(float lo, float hi) { unsigned r; asm volatile("v_cvt_pk_bf16_f32 %0, %1, %2" : "=v"(r) : "v"(lo), "v"(hi)); return r; }
typedef float f32x2 __attribute__((ext_vector_type(2)));
typedef float f32x2 __attribute__((ext_vector_type(2)));
typedef __bf16 bf16x2_t __attribute__((ext_vector_type(2)));
__device__ __forceinline__ unsigned cvtpk(float lo, float hi) { f32x2 v = {lo, hi}; bf16x2_t b = __builtin_convertvector(v, bf16x2_t); return __builtin_bit_cast(unsigned, b); }
__device__ __forceinline__ bf16_t cvt1(float v) { return (bf16_t)(cvtpk(v, 0.f) & 0xffffu); }

struct EpiProj {
    static constexpr bool PERM = true, AFTER_DRAIN = false;
    bf16_t* QK; bf16_t* VT; const float* rope;
    __device__ __forceinline__ void operator()(const f32x4 (&acc)[2][2][4][2], const Unit& u, int wr, int wc, int fr, int fq) const {
        const int pn = u.pn;
        const int row0 = u.pm * BM + wr * 64 + fr;
        const int cin = wc * 32 + 8 * fq;
        if (pn == 4 || pn == 5 || pn == 8 || pn == 11) {
            const size_t voff = (pn <= 5) ? (size_t)0 : (pn == 8 ? VTB_OFF : VTC_OFF);
            bf16_t* base = VT + voff;
            const int nd = (pn <= 5) ? 128 : 64, c0 = (pn == 5) ? 256 : 0;
#pragma unroll
            for (int ai = 0; ai < 2; ++ai)
#pragma unroll
                for (int m = 0; m < 4; ++m) {
                    const int row = row0 + ai * HALF + m * 16, b = row >> 12, s = row & (SEQ - 1);
#pragma unroll
                    for (int bj = 0; bj < 2; ++bj) {
                        const int c = c0 + bj * HALF + cin;
                        const int h = c / nd, e = c % nd;
                        bf16_t* p = base + ((size_t)((b * 4 + h) * nd + e)) * SEQ + s;
#pragma unroll
                        for (int n = 0; n < 2; ++n)
#pragma unroll
                            for (int i = 0; i < 4; ++i) p[(size_t)(4 * n + i) * SEQ] = cvt1(acc[ai][bj][m][n][i]);
                    }
                }
            return;
        }
        int dcol; bool rope_on = false; float sc = 1.f;
        if (pn <= 1) { dcol = pn * 256; rope_on = true; sc = QSCALE; }
        else if (pn <= 3) { dcol = 512 + (pn - 2) * 256; rope_on = true; }
        else if (pn == 6) { dcol = 1024; sc = QSCALE; }
        else if (pn == 7) { dcol = 1280; }
        else if (pn == 9) { dcol = 1536; sc = QSCALE; }
        else { dcol = 1792; }
        const bool rl = ((wc & 1) == 0) && (fq < 2);
#pragma unroll
        for (int ai = 0; ai < 2; ++ai)
#pragma unroll
            for (int m = 0; m < 4; ++m) {
                const int row = row0 + ai * HALF + m * 16;
#pragma unroll
                for (int bj = 0; bj < 2; ++bj) {
                    f32x4 v0 = acc[ai][bj][m][0], v1 = acc[ai][bj][m][1];
                    if (rope_on) {
                        f32x4 o0, o1;
#pragma unroll
                        for (int i = 0; i < 4; ++i) { o0[i] = __shfl_xor(v0[i], 16); o1[i] = __shfl_xor(v1[i], 16); }
                        if (rl) {
                            const f32x4* t = (const f32x4*)(rope + (size_t)(row & (SEQ - 1)) * 16);
                            const f32x4 c0 = t[0], c1 = t[1], s0 = t[2], s1 = t[3];
                            if (fq == 0) { v0 = v0 * c0 - o0 * s0; v1 = v1 * c1 - o1 * s1; }
                            else         { v0 = v0 * c0 + o0 * s0; v1 = v1 * c1 + o1 * s1; }
                        }
                    }
                    v0 = v0 * sc; v1 = v1 * sc;
                    u32x4 w; w.x = cvtpk(v0[0], v0[1]); w.y = cvtpk(v0[2], v0[3]); w.z = cvtpk(v1[0], v1[1]); w.w = cvtpk(v1[2], v1[3]);
                    *(u32x4*)(QK + (size_t)row * QKP + dcol + bj * HALF + cin) = w;
                }
            }
    }
};
struct EpiF32 {
    static constexpr bool PERM = true, AFTER_DRAIN = false;
    float* O; int ldc;
    __device__ __forceinline__ void operator()(const f32x4 (&acc)[2][2][4][2], const Unit& u, int wr, int wc, int fr, int fq) const {
        const int row0 = u.pm * BM + wr * 64 + fr, col0 = u.pn * BM + wc * 32 + 8 * fq;
#pragma unroll
        for (int ai = 0; ai < 2; ++ai)
#pragma unroll
            for (int m = 0; m < 4; ++m) { float* rowp = O + (size_t)(row0 + ai * HALF + m * 16) * ldc + col0;
#pragma unroll
                for (int bj = 0; bj < 2; ++bj) { *(f32x4*)(rowp + bj * HALF) = acc[ai][bj][m][0]; *(f32x4*)(rowp + bj * HALF + 4) = acc[ai][bj][m][1]; } }
    }
};
struct EpiRelu2 {
    static constexpr bool PERM = true, AFTER_DRAIN = false;
    bf16_t* O; int ldc;
    __device__ __forceinline__ void operator()(const f32x4 (&acc)[2][2][4][2], const Unit& u, int wr, int wc, int fr, int fq) const {
        const int row0 = u.pm * BM + wr * 64 + fr, col0 = u.pn * BM + wc * 32 + 8 * fq;
#pragma unroll
        for (int ai = 0; ai < 2; ++ai)
#pragma unroll
            for (int m = 0; m < 4; ++m) { bf16_t* rowp = O + (size_t)(row0 + ai * HALF + m * 16) * ldc + col0;
#pragma unroll
                for (int bj = 0; bj < 2; ++bj) { f32x4 v0 = acc[ai][bj][m][0], v1 = acc[ai][bj][m][1];
#pragma unroll
                    for (int i = 0; i < 4; ++i) { const float a = fmaxf(v0[i], 0.f), b = fmaxf(v1[i], 0.f); v0[i] = a * a; v1[i] = b * b; }
                    u32x4 w; w.x = cvtpk(v0[0], v0[1]); w.y = cvtpk(v0[2], v0[3]); w.z = cvtpk(v1[0], v1[1]); w.w = cvtpk(v1[2], v1[3]);
                    *(u32x4*)(rowp + bj * HALF) = w; } }
    }
};

template <class Epi, class Sched, bool ALIGN_EPI = false, bool SP2 = false>
__device__ __forceinline__ void gemm_phase(PG8_LAS unsigned char* lds, const Gemm g, const Sched& S, const Epi& E) {
    const int tid = fresh_tid(), wid = __builtin_amdgcn_readfirstlane(tid >> 6), lane = tid & 63, wr = wid >> 2, wc = wid & 3, fr = lane & 15, fq = lane >> 4;
    const int K = g.K, nt = K / BK;
    unsigned voffA[2], voffB[2];
#pragma unroll
    for (int i = 0; i < 2; ++i) { int R, C; stage_rc(tid * 16 + i * 8192, R, C); const int Rb = Epi::PERM ? ((R & ~31) + perm32(R & 31)) : R;
        voffA[i] = (unsigned)(R * K + C) * 2u; voffB[i] = (unsigned)(Rb * K + C) * 2u; }
    const size_t kstep = (size_t)(BK * 2);
    const size_t hstep = (size_t)HALF * K * 2;
    const size_t tstep = 2 * hstep;
    const unsigned ldsw = (unsigned)wid * 1024u;
    const int aoff = lds_byte(wr * 64 + fr, fq * 8), boff = lds_byte(wc * 32 + fr, fq * 8);
#define PG8_SA(b, h) (((b) * 2 + (h)) * HTB)
#define PG8_SB(b, h) ((4 + (b) * 2 + (h)) * HTB)
#define PG8_STAGE(bufoff, gbase, voff) do { _Pragma("unroll") for (int _i = 0; _i < 2; ++_i) \
        __builtin_amdgcn_global_load_lds((const unsigned*)((const char*)(gbase) + (voff)[_i]), (PG8_LAS unsigned*)(lds + (bufoff) + ldsw + _i * 8192), 16, 0, 0); } while (0)
#define PG8_LDA(dst, b, h) do { _Pragma("unroll") for (int m = 0; m < 4; ++m) _Pragma("unroll") for (int k = 0; k < 2; ++k) dst[m][k] = *(const PG8_LAS bf16x8*)(lds + PG8_SA(b, h) + aoff + m * 2048 + k * 1024); } while (0)
#define PG8_LDB(dst, b, h) do { _Pragma("unroll") for (int n = 0; n < 2; ++n) _Pragma("unroll") for (int k = 0; k < 2; ++k) dst[n][k] = *(const PG8_LAS bf16x8*)(lds + PG8_SB(b, h) + boff + n * 2048 + k * 1024); } while (0)
#define PG8_MMA(ai, bj, At, Bt) do { __builtin_amdgcn_s_setprio(1); _Pragma("unroll") for (int m = 0; m < 4; ++m) _Pragma("unroll") for (int n = 0; n < 2; ++n) _Pragma("unroll") for (int k = 0; k < 2; ++k) \
        acc[ai][bj][m][n] = __builtin_amdgcn_mfma_f32_16x16x32_bf16(Bt[n][k], At[m][k], acc[ai][bj][m][n], 0, 0, 0); __builtin_amdgcn_s_setprio(0); } while (0)
#define PG8_WAIT_V(n) asm volatile("s_waitcnt vmcnt(" #n ")" ::: "memory")
#define PG8_WAIT_L(n) asm volatile("s_waitcnt lgkmcnt(" #n ")" ::: "memory")
#define PG8_BAR __builtin_amdgcn_s_barrier()
#define PG8_SCHED __builtin_amdgcn_sched_barrier(0)
    Unit cur, nxt; int ui = 0;
    if (!S.next(0, cur)) return;
    f32x4 acc[2][2][4][2];
#pragma unroll
    for (int a = 0; a < 2; ++a)
#pragma unroll
        for (int b = 0; b < 2; ++b)
#pragma unroll
            for (int m = 0; m < 4; ++m)
#pragma unroll
                for (int n = 0; n < 2; ++n) acc[a][b][m][n] = (f32x4){0.f, 0.f, 0.f, 0.f};
    bf16x8 At[4][2], B0[2][2], B1[2][2];
    const char* cA = (const char*)g.A + (size_t)cur.pm * tstep; const char* cB = (const char*)g.Bt + (size_t)cur.pn * tstep;
    S.a_ready(cur);
    if constexpr (SP2) {
        PG8_STAGE(PG8_SB(0, 0), cB, voffB); PG8_STAGE(PG8_SB(0, 1), cB + hstep, voffB); PG8_STAGE(PG8_SA(0, 0), cA, voffA); PG8_STAGE(PG8_SA(0, 1), cA + hstep, voffA);
        if (wr == 1) PG8_BAR;
        PG8_WAIT_V(2); PG8_BAR;
        PG8_STAGE(PG8_SB(1, 0), cB + kstep, voffB); PG8_STAGE(PG8_SA(1, 0), cA + kstep, voffA); PG8_STAGE(PG8_SB(1, 1), cB + hstep + kstep, voffB);
        PG8_WAIT_V(6); PG8_BAR;
    } else {
        PG8_STAGE(PG8_SB(0, 0), cB, voffB); PG8_STAGE(PG8_SA(0, 0), cA, voffA); PG8_STAGE(PG8_SB(0, 1), cB + hstep, voffB); PG8_STAGE(PG8_SA(0, 1), cA + hstep, voffA);
        if (wr == 1) PG8_BAR;
        PG8_WAIT_V(4); PG8_BAR;
        PG8_STAGE(PG8_SB(1, 0), cB + kstep, voffB); PG8_STAGE(PG8_SA(1, 0), cA + kstep, voffA); PG8_STAGE(PG8_SB(1, 1), cB + hstep + kstep, voffB);
        PG8_WAIT_V(6); PG8_BAR;
    }
    for (;;) {
        const bool has_next = S.next(ui + 1, nxt);
        const char* nA = has_next ? (const char*)g.A + (size_t)nxt.pm * tstep : cA; const char* nB = has_next ? (const char*)g.Bt + (size_t)nxt.pn * tstep : cB;
        for (int t = 0; t < nt; t += 2) {
            const bool last = (t == nt - 2);
            const char* a1 = cA + (size_t)(t + 1) * kstep;
            const char* a2 = last ? nA : cA + (size_t)(t + 2) * kstep; const char* b2 = last ? nB : cB + (size_t)(t + 2) * kstep;
            const char* a3 = a2 + kstep; const char* b3 = b2 + kstep;
            if (last && has_next) S.a_ready(nxt);
            if constexpr (SP2) {
            PG8_LDB(B0, 0, 0); PG8_LDB(B1, 0, 1); PG8_SCHED; PG8_LDA(At, 0, 0); PG8_STAGE(PG8_SA(1, 1), a1 + hstep, voffA);
            PG8_WAIT_V(8); PG8_WAIT_L(0); PG8_BAR; PG8_MMA(0, 0, At, B0); PG8_MMA(0, 1, At, B1); PG8_BAR; PG8_SCHED;
            PG8_LDA(At, 0, 1); PG8_STAGE(PG8_SB(0, 0), b2, voffB); PG8_STAGE(PG8_SB(0, 1), b2 + hstep, voffB); PG8_STAGE(PG8_SA(0, 0), a2, voffA);
            PG8_WAIT_V(8); PG8_WAIT_L(0); PG8_BAR; PG8_MMA(1, 0, At, B0); PG8_MMA(1, 1, At, B1); PG8_BAR; PG8_SCHED;
            PG8_LDB(B0, 1, 0); PG8_LDB(B1, 1, 1); PG8_SCHED; PG8_LDA(At, 1, 0); PG8_STAGE(PG8_SA(0, 1), a2 + hstep, voffA);
            PG8_WAIT_V(8); PG8_WAIT_L(0); PG8_BAR; PG8_MMA(0, 0, At, B0); PG8_MMA(0, 1, At, B1); PG8_BAR; PG8_SCHED;
            PG8_LDA(At, 1, 1); PG8_STAGE(PG8_SB(1, 0), b3, voffB); PG8_STAGE(PG8_SB(1, 1), b3 + hstep, voffB); PG8_STAGE(PG8_SA(1, 0), a3, voffA);
            PG8_WAIT_V(8); PG8_WAIT_L(0); PG8_BAR; PG8_MMA(1, 0, At, B0); PG8_MMA(1, 1, At, B1); PG8_BAR; PG8_SCHED;
            } else {
            PG8_LDB(B0, 0, 0); PG8_SCHED; PG8_LDA(At, 0, 0); PG8_STAGE(PG8_SA(1, 1), a1 + hstep, voffA);
            PG8_WAIT_L(8); PG8_BAR; PG8_WAIT_L(0); PG8_MMA(0, 0, At, B0); PG8_BAR; PG8_SCHED;
            PG8_LDB(B1, 0, 1); PG8_STAGE(PG8_SB(0, 0), b2, voffB);
            PG8_BAR; PG8_WAIT_L(0); PG8_MMA(0, 1, At, B1); PG8_BAR;
            PG8_LDA(At, 0, 1); PG8_STAGE(PG8_SA(0, 0), a2, voffA);
            PG8_BAR; PG8_WAIT_L(0); PG8_MMA(1, 0, At, B0); PG8_BAR; PG8_SCHED;
            PG8_STAGE(PG8_SB(0, 1), b2 + hstep, voffB);
            PG8_WAIT_V(6); PG8_BAR; PG8_MMA(1, 1, At, B1); PG8_BAR;
            PG8_LDB(B0, 1, 0); PG8_SCHED; PG8_LDA(At, 1, 0); PG8_STAGE(PG8_SA(0, 1), a2 + hstep, voffA);
            PG8_WAIT_L(8); PG8_BAR; PG8_WAIT_L(0); PG8_MMA(0, 0, At, B0); PG8_BAR; PG8_SCHED;
            PG8_LDB(B1, 1, 1); PG8_STAGE(PG8_SB(1, 0), b3, voffB);
            PG8_BAR; PG8_WAIT_L(0); PG8_MMA(0, 1, At, B1); PG8_BAR;
            PG8_LDA(At, 1, 1); PG8_STAGE(PG8_SA(1, 0), a3, voffA);
            PG8_BAR; PG8_WAIT_L(0); PG8_MMA(1, 0, At, B0); PG8_BAR; PG8_SCHED;
            PG8_STAGE(PG8_SB(1, 1), b3 + hstep, voffB);
            PG8_WAIT_V(6); PG8_BAR; PG8_MMA(1, 1, At, B1); PG8_BAR;
            }
        }
        if constexpr (ALIGN_EPI) { if (wr == 0) PG8_BAR; }
        if constexpr (!Epi::AFTER_DRAIN) { E(acc, cur, wr, wc, fr, fq); S.done(cur); }
        if (!has_next) break;
#pragma unroll
        for (int a = 0; a < 2; ++a)
#pragma unroll
            for (int b = 0; b < 2; ++b)
#pragma unroll
                for (int m = 0; m < 4; ++m)
#pragma unroll
                    for (int n = 0; n < 2; ++n) acc[a][b][m][n] = (f32x4){0.f, 0.f, 0.f, 0.f};
        cur = nxt; cA = nA; cB = nB; ++ui;
        if constexpr (ALIGN_EPI) { if (wr == 1) PG8_BAR; }
    }
    PG8_WAIT_V(0);
    if constexpr (!ALIGN_EPI) { if (wr == 0) PG8_BAR; }
    PG8_BAR;
    if constexpr (Epi::AFTER_DRAIN) { E.fused(acc, cur, wr, wc, fr, fq, lds, wid, lane); S.done(cur); }
#undef PG8_SA
#undef PG8_SB
#undef PG8_STAGE
#undef PG8_LDA
#undef PG8_LDB
#undef PG8_MMA
#undef PG8_WAIT_V
#undef PG8_WAIT_L
#undef PG8_BAR
#undef PG8_SCHED
}
}

#define LAS __attribute__((address_space(3)))
typedef unsigned short bf16_t;
typedef short bf16x8 __attribute__((ext_vector_type(8)));
typedef float f32x4 __attribute__((ext_vector_type(4)));
typedef float f32x16 __attribute__((ext_vector_type(16)));
typedef unsigned u32x4 __attribute__((ext_vector_type(4)));
typedef unsigned u32x2 __attribute__((ext_vector_type(2)));
using pg8::cvtpk;
#define MFMA32(a, b, c) __builtin_amdgcn_mfma_f32_32x32x16_bf16((a), (b), (c), 0, 0, 0)
__device__ __forceinline__ float wave_sum(float v) {
#pragma unroll
    for (int o = 1; o < 64; o <<= 1) v += __shfl_xor(v, o);
    return v;
}
__device__ __forceinline__ float ex2(float x) { return __builtin_amdgcn_exp2f(x); }
__device__ __forceinline__ float lg2(float x) { return __builtin_amdgcn_logf(x); }

constexpr size_t MiB = 1u << 20;
constexpr size_t WS_ROPE = 1 * MiB;
constexpr size_t WS_WI = 2 * MiB, WS_WO = 8 * MiB, WS_WU = 10 * MiB, WS_WD = 18 * MiB;
constexpr size_t WS_HN = 26 * MiB;
constexpr size_t WS_Y = 58 * MiB;
constexpr size_t WS_QK = 58 * MiB;
constexpr size_t WS_U = 122 * MiB;
constexpr size_t WS_VTA = 122 * MiB, WS_VTB = 138 * MiB, WS_VTC = 146 * MiB;
constexpr size_t WS_OA = 154 * MiB;
constexpr size_t WS_CAT = 218 * MiB;
constexpr size_t WS_END = 250 * MiB;
static_assert(WS_VTB - WS_VTA == VTB_OFF * 2 && WS_VTC - WS_VTA == VTC_OFF * 2, "V^T offsets");

namespace att {
constexpr int KROW = 144;
constexpr int KBUF = 64 * KROW, VBUF = 128 * KROW;
constexpr int L_K0 = 0, L_K1 = KBUF, L_V0 = 2 * KBUF, L_V1 = 2 * KBUF + VBUF, L_MISC = 2 * KBUF + 2 * VBUF;
constexpr int L_RB = L_MISC, L_FLAG = L_MISC + 2048;

template <int DV> struct TileRegs { u32x4 k; u32x4 v[DV / 64]; };
template <int DV> __device__ __forceinline__ void tile_load(TileRegs<DV>& r, const bf16_t* Kb, const bf16_t* Vb, int key0, int tid) {
    const int row = tid >> 3, ch = tid & 7;
    r.k = *(const u32x4*)(Kb + (size_t)(key0 + row) * QKP + ch * 8);
#pragma unroll
    for (int i = 0; i < DV / 64; ++i) r.v[i] = *(const u32x4*)(Vb + (size_t)(row + 64 * i) * SEQ + key0 + ch * 8);
}
template <int DV> __device__ __forceinline__ void tile_store(const TileRegs<DV>& r, LAS unsigned char* lds, int kbuf, int vbuf, int tid) {
    const int row = tid >> 3, ch = tid & 7;
    *(LAS u32x4*)(lds + kbuf + row * KROW + ch * 16) = r.k;
#pragma unroll
    for (int i = 0; i < DV / 64; ++i) *(LAS u32x4*)(lds + vbuf + (row + 64 * i) * KROW + ch * 16) = r.v[i];
}
__device__ __forceinline__ void qk_tile(f32x16& s0, f32x16& s1, LAS const unsigned char* kp, const bf16x8 (&q)[4]) {
#pragma unroll
    for (int i = 0; i < 16; ++i) { s0[i] = 0.f; s1[i] = 0.f; }
#pragma unroll
    for (int d0 = 0; d0 < 4; ++d0) {
        const bf16x8 a0 = *(LAS const bf16x8*)(kp + d0 * 32), a1 = *(LAS const bf16x8*)(kp + 32 * KROW + d0 * 32);
        s0 = MFMA32(a0, q[d0], s0); s1 = MFMA32(a1, q[d0], s1);
    }
}
__device__ __forceinline__ bf16x8 pack8(const f32x16& s, int b) {
    u32x4 w; w.x = cvtpk(s[b], s[b + 1]); w.y = cvtpk(s[b + 2], s[b + 3]); w.z = cvtpk(s[b + 4], s[b + 5]); w.w = cvtpk(s[b + 6], s[b + 7]);
    return __builtin_bit_cast(bf16x8, w);
}
template <int NDB> __device__ __forceinline__ void pv_tile(f32x16 (&o)[NDB], LAS const unsigned char* vp, const bf16x8 (&pf)[4]) {
#pragma unroll
    for (int db = 0; db < NDB; ++db)
#pragma unroll
        for (int kg = 0; kg < 4; ++kg) { const bf16x8 a = *(LAS const bf16x8*)(vp + db * 32 * KROW + kg * 32); o[db] = MFMA32(a, pf[kg], o[db]); }
}
template <int NDB> __device__ __forceinline__ void softmax_update(f32x16& s0, f32x16& s1, float& m, float& l, f32x16 (&o)[NDB], LAS const unsigned char* vp) {
    float mx = fmaxf(s0[0], s1[0]);
#pragma unroll
    for (int i = 1; i < 16; ++i) mx = fmaxf(mx, fmaxf(s0[i], s1[i]));
    mx = fmaxf(mx, __shfl_xor(mx, 32));
    const float mn = fmaxf(m, mx), alpha = ex2(m - mn); m = mn;
    float ps = 0.f;
#pragma unroll
    for (int i = 0; i < 16; ++i) { s0[i] = ex2(s0[i] - mn); s1[i] = ex2(s1[i] - mn); ps += s0[i] + s1[i]; }
    l = l * alpha + ps;
#pragma unroll
    for (int db = 0; db < NDB; ++db) o[db] = o[db] * alpha;
    bf16x8 pf[4]; pf[0] = pack8(s0, 0); pf[1] = pack8(s0, 8); pf[2] = pack8(s1, 0); pf[3] = pack8(s1, 8);
    pv_tile<NDB>(o, vp, pf);
}
struct Lane { int tid, wid, lane, rho, hi, koff, voff; };
__device__ __forceinline__ Lane make_lane() {
    Lane L; L.tid = fresh_tid(); L.wid = __builtin_amdgcn_readfirstlane(L.tid >> 6); L.lane = L.tid & 63; L.rho = L.lane & 31; L.hi = L.lane >> 5;
    const int pr = (L.rho & ~12) | ((L.rho & 4) << 1) | ((L.rho & 8) >> 1);
    L.koff = pr * KROW + L.hi * 16; L.voff = L.rho * KROW + L.hi * 16; return L;
}
__device__ __forceinline__ void load_q(bf16x8 (&q)[4], const bf16_t* Qrow  ) {
#pragma unroll
    for (int d0 = 0; d0 < 4; ++d0) q[d0] = *(const bf16x8*)(Qrow + d0 * 16);
}

__device__ __forceinline__ void attnA_item(LAS unsigned char* lds, const Lane& L, const bf16_t* QK, const bf16_t* VTa, float* OA, int b, int h, int n, int qblk) {
    const int rowq = qblk * 256 + L.wid * 32, cw = rowq >> 6;
    const size_t tok0 = (size_t)b * SEQ;
    bf16x8 q[4]; load_q(q, QK + (tok0 + rowq + L.rho) * QKP + h * 128 + n * 64 + L.hi * 8);
    const bf16_t* Kb = QK + tok0 * QKP + 512 + h * 128 + n * 64;
    const bf16_t* Vb = VTa + (size_t)((b * 4 + h) * 128) * SEQ;
    const int NT = 4 * qblk + 4;
    TileRegs<128> tr;
    tile_load<128>(tr, Kb, Vb, 0, L.tid); tile_store<128>(tr, lds, L_K0, L_V0, L.tid); __syncthreads();
    float m = -1e30f, l = 0.f; f32x16 o[4];
#pragma unroll
    for (int db = 0; db < 4; ++db)
#pragma unroll
        for (int i = 0; i < 16; ++i) o[db][i] = 0.f;
    for (int t = 0; t < NT; ++t) {
        const int cur = t & 1;
        if (t + 1 < NT) tile_load<128>(tr, Kb, Vb, (t + 1) * 64, L.tid);
        if (t <= cw) {
            f32x16 s0, s1; qk_tile(s0, s1, lds + (cur ? L_K1 : L_K0) + L.koff, q);
            softmax_update<4>(s0, s1, m, l, o, lds + (cur ? L_V1 : L_V0) + L.voff);
        }
        if (t + 1 < NT) tile_store<128>(tr, lds, cur ? L_K0 : L_K1, cur ? L_V0 : L_V1, L.tid);
        __syncthreads();
    }
    l += __shfl_xor(l, 32);
    const float inv = 1.0f / l;
    float* op = OA + ((size_t)n * NTOK + tok0 + rowq + L.rho) * 512 + h * 128 + 4 * L.hi;
#pragma unroll
    for (int db = 0; db < 4; ++db)
#pragma unroll
        for (int g = 0; g < 4; ++g) { f32x4 v = {o[db][4 * g], o[db][4 * g + 1], o[db][4 * g + 2], o[db][4 * g + 3]}; *(f32x4*)(op + db * 32 + 8 * g) = v * inv; }
}
__device__ __forceinline__ void store_head_norm(const f32x16 (&o)[2], const Lane& L, const float* gain  , bf16_t* dst  ) {
    float ss = 0.f;
#pragma unroll
    for (int db = 0; db < 2; ++db)
#pragma unroll
        for (int i = 0; i < 16; ++i) ss += o[db][i] * o[db][i];
    ss += __shfl_xor(ss, 32);
    const float rs = rsqrtf(ss * (1.0f / 64.0f) + RMS_EPS);
#pragma unroll
    for (int db = 0; db < 2; ++db)
#pragma unroll
        for (int g = 0; g < 4; ++g) { const int d = db * 32 + 8 * g + 4 * L.hi; const f32x4 gv = *(const f32x4*)(gain + d);
            u32x2 w; w.x = cvtpk(o[db][4 * g] * rs * gv[0], o[db][4 * g + 1] * rs * gv[1]); w.y = cvtpk(o[db][4 * g + 2] * rs * gv[2], o[db][4 * g + 3] * rs * gv[3]);
            *(u32x2*)(dst + d) = w; }
}
__device__ __forceinline__ void attnB_item(LAS unsigned char* lds, const Lane& L, const bf16_t* QK, const bf16_t* VTb, bf16_t* CAT, const float* relb  , const float* gnb, int b, int h, int qblk) {
    const int rowq = qblk * 256 + L.wid * 32, cw = rowq >> 6;
    const size_t tok0 = (size_t)b * SEQ;
    LAS float* rb = (LAS float*)(lds + L_RB);
    if (L.tid < 257) rb[L.tid] = relb[h * 257 + L.tid] * LOG2E;
    bf16x8 q[4]; load_q(q, QK + (tok0 + rowq + L.rho) * QKP + 1024 + h * 64 + L.hi * 8);
    const bf16_t* Kb = QK + tok0 * QKP + 1280 + h * 64;
    const bf16_t* Vb = VTb + (size_t)((b * 4 + h) * 64) * SEQ;
    const int t_lo = (4 * qblk - 8) > 0 ? (4 * qblk - 8) : 0, t_hi = 4 * qblk + 3;
    TileRegs<64> tr;
    tile_load<64>(tr, Kb, Vb, t_lo * 64, L.tid); tile_store<64>(tr, lds, L_K0, L_V0, L.tid); __syncthreads();
    float m = -1e30f, l = 0.f; f32x16 o[2];
#pragma unroll
    for (int db = 0; db < 2; ++db)
#pragma unroll
        for (int i = 0; i < 16; ++i) o[db][i] = 0.f;
    const int qpos = rowq + L.rho;
    for (int t = t_lo; t <= t_hi; ++t) {
        const int cur = (t - t_lo) & 1;
        if (t < t_hi) tile_load<64>(tr, Kb, Vb, (t + 1) * 64, L.tid);
        if (t <= cw && t >= cw - 8) {
            f32x16 s0, s1; qk_tile(s0, s1, lds + (cur ? L_K1 : L_K0) + L.koff, q);
            if (cw - t >= 3) {
                const float bc = rb[256];
#pragma unroll
                for (int i = 0; i < 16; ++i) { s0[i] += bc; s1[i] += bc; }
            } else {
                const int rel0 = qpos - (t * 64 + 8 * L.hi);
#pragma unroll
                for (int r = 0; r < 16; ++r) { const int ko = 16 * (r >> 3) + (r & 7);
                    int i0 = rel0 - ko; i0 = (i0 > 128 ? 128 : i0) + 128; int i1 = rel0 - 32 - ko; i1 = (i1 > 128 ? 128 : i1) + 128;
                    s0[r] += rb[i0]; s1[r] += rb[i1]; }
            }
            softmax_update<2>(s0, s1, m, l, o, lds + (cur ? L_V1 : L_V0) + L.voff);
        }
        if (t < t_hi) tile_store<64>(tr, lds, cur ? L_K0 : L_K1, cur ? L_V0 : L_V1, L.tid);
        __syncthreads();
    }
    l += __shfl_xor(l, 32);
    const float inv = 1.0f / l;
#pragma unroll
    for (int db = 0; db < 2; ++db) o[db] = o[db] * inv;
    store_head_norm(o, L, gnb + h * 64, CAT + (tok0 + rowq + L.rho) * 1024 + 512 + h * 64);
}
__device__ __forceinline__ void stick_block(const f32x16& y, int kbase, int lim, int hi, float& R, bf16x8& pf0, bf16x8& pf1) {
    f32x16 ls, lb;
#pragma unroll
    for (int r = 0; r < 16; ++r) {
        const int kpos = kbase + 16 * (r >> 3) + 8 * hi + (r & 7);
        const float yy = y[r], sp = fmaxf(yy, 0.f) + lg2(1.0f + ex2(-fabsf(yy)));
        const bool valid = kpos < lim;
        ls[r] = valid ? -sp : 0.f;
        lb[r] = valid ? (yy - sp) : -1e30f;
    }
    float g0 = 0.f, g1 = 0.f;
#pragma unroll
    for (int i = 0; i < 8; ++i) { g0 += ls[i]; g1 += ls[8 + i]; }
    const float p0 = __shfl_xor(g0, 32), p1 = __shfl_xor(g1, 32);
    const float G11 = hi ? g1 : p1, G01 = hi ? p1 : g1, G10 = hi ? g0 : p0, G00 = hi ? p0 : g0;
    float run1 = R + (hi ? 0.f : G11);
    float run0 = R + (G11 + G01) + (hi ? 0.f : G10);
    f32x16 a;
#pragma unroll
    for (int i = 7; i >= 0; --i) {
        a[8 + i] = ex2(lb[8 + i] + run1); run1 += ls[8 + i];
        a[i] = ex2(lb[i] + run0); run0 += ls[i];
    }
    R += (G11 + G01) + (G10 + G00);
    pf0 = pack8(a, 0); pf1 = pack8(a, 8);
}
__device__ __forceinline__ void attnC_item(LAS unsigned char* lds, const Lane& L, const bf16_t* QK, const bf16_t* VTc, bf16_t* CAT, const float* gnc, int b, int h, int qblk) {
    const int rowq = qblk * 256 + L.wid * 32, cw = rowq >> 6;
    const size_t tok0 = (size_t)b * SEQ;
    volatile LAS unsigned* flag = (volatile LAS unsigned*)(lds + L_FLAG);
    bf16x8 q[4]; load_q(q, QK + (tok0 + rowq + L.rho) * QKP + 1536 + h * 64 + L.hi * 8);
    const bf16_t* Kb = QK + tok0 * QKP + 1792 + h * 64;
    const bf16_t* Vb = VTc + (size_t)((b * 4 + h) * 64) * SEQ;
    const int t_hi = 4 * qblk + 3;
    TileRegs<64> tr;
    tile_load<64>(tr, Kb, Vb, t_hi * 64, L.tid); tile_store<64>(tr, lds, L_K0, L_V0, L.tid); __syncthreads();
    float R = 0.f; f32x16 o[2];
#pragma unroll
    for (int db = 0; db < 2; ++db)
#pragma unroll
        for (int i = 0; i < 16; ++i) o[db][i] = 0.f;
    const int qpos = rowq + L.rho;
    bool wdone = false;
    for (int t = t_hi; t >= 0; --t) {
        const int it = t_hi - t, cur = it & 1;
        if (t > 0) tile_load<64>(tr, Kb, Vb, (t - 1) * 64, L.tid);
        if (t <= cw && !wdone) {
            f32x16 s0, s1; qk_tile(s0, s1, lds + (cur ? L_K1 : L_K0) + L.koff, q);
            const int lim = (t == cw) ? qpos : 0x7fffffff;
            bf16x8 pf[4];
            stick_block(s1, t * 64 + 32, lim, L.hi, R, pf[2], pf[3]);
            stick_block(s0, t * 64, lim, L.hi, R, pf[0], pf[1]);
            pv_tile<2>(o, lds + (cur ? L_V1 : L_V0) + L.voff, pf);
            wdone = __all(R < -150.0f) != 0;
        }
        if (L.lane == 0) flag[cur * 8 + L.wid] = (wdone || t == 0) ? 1u : 0u;
        if (t > 0) tile_store<64>(tr, lds, cur ? L_K0 : L_K1, cur ? L_V0 : L_V1, L.tid);
        __syncthreads();
        unsigned alld = 1u;
#pragma unroll
        for (int w = 0; w < 8; ++w) alld &= flag[cur * 8 + w];
        if (alld) break;
    }
    __syncthreads();
    store_head_norm(o, L, gnc + h * 64, CAT + (tok0 + rowq + L.rho) * 1024 + 768 + h * 64);
}
}

__device__ __forceinline__ void store_row_bf16(bf16_t* orow, const f32x4 (&v)[4], int lane) {
#pragma unroll
    for (int j = 0; j < 4; ++j) { u32x2 w; w.x = cvtpk(v[j][0], v[j][1]); w.y = cvtpk(v[j][2], v[j][3]); *((u32x2*)orow + lane + 64 * j) = w; }
}
__device__ __forceinline__ void prenorm_pass(const float* x, const float* g, bf16_t* HN, int gw, int NGW, int lane) {
    for (int m = gw; m < NTOK; m += NGW) {
        const f32x4* xr = (const f32x4*)(x + (size_t)m * DM) + lane; f32x4 v[4]; float s = 0.f;
#pragma unroll
        for (int j = 0; j < 4; ++j) { v[j] = xr[64 * j]; s += (v[j][0] * v[j][0] + v[j][1] * v[j][1]) + (v[j][2] * v[j][2] + v[j][3] * v[j][3]); }
        const float rs = rsqrtf(wave_sum(s) * (1.0f / DM) + RMS_EPS);
#pragma unroll
        for (int j = 0; j < 4; ++j) v[j] = v[j] * rs * ((const f32x4*)g)[lane + 64 * j];
        store_row_bf16(HN + (size_t)m * DM, v, lane);
    }
}
__device__ __forceinline__ void postnorm_pass(const float* Y, const float* xin, float* xout, const float* gpost, const float* gnext, bf16_t* HN, int gw, int NGW, int lane) {
    for (int m = gw; m < NTOK; m += NGW) {
        const f32x4* yr = (const f32x4*)(Y + (size_t)m * DM) + lane; const f32x4* xr = (const f32x4*)(xin + (size_t)m * DM) + lane;
        f32x4 y[4], v[4]; float s = 0.f;
#pragma unroll
        for (int j = 0; j < 4; ++j) { y[j] = yr[64 * j]; v[j] = xr[64 * j]; s += (y[j][0] * y[j][0] + y[j][1] * y[j][1]) + (y[j][2] * y[j][2] + y[j][3] * y[j][3]); }
        const float rs = rsqrtf(wave_sum(s) * (1.0f / DM) + RMS_EPS);
        float s2 = 0.f;
#pragma unroll
        for (int j = 0; j < 4; ++j) { v[j] = v[j] + y[j] * rs * ((const f32x4*)gpost)[lane + 64 * j]; s2 += (v[j][0] * v[j][0] + v[j][1] * v[j][1]) + (v[j][2] * v[j][2] + v[j][3] * v[j][3]); }
        f32x4* xo = (f32x4*)(xout + (size_t)m * DM) + lane;
#pragma unroll
        for (int j = 0; j < 4; ++j) xo[64 * j] = v[j];
        if (gnext) {
            const float rs2 = rsqrtf(wave_sum(s2) * (1.0f / DM) + RMS_EPS);
#pragma unroll
            for (int j = 0; j < 4; ++j) v[j] = v[j] * rs2 * ((const f32x4*)gnext)[lane + 64 * j];
            store_row_bf16(HN + (size_t)m * DM, v, lane);
        }
    }
}
__device__ __forceinline__ void combine_pass(const float* OA, bf16_t* CAT, const float* subln, float lam, float oscale, int gw, int NGW, int lane) {
    const int e0 = (lane & 15) * 8;
    const f32x4 g0 = *(const f32x4*)(subln + e0), g1 = *(const f32x4*)(subln + e0 + 4);
    for (int m = gw; m < NTOK; m += NGW) {
        const f32x4* a = (const f32x4*)(OA + (size_t)m * 512) + 2 * lane; const f32x4* c = (const f32x4*)(OA + ((size_t)NTOK + m) * 512) + 2 * lane;
        f32x4 d0 = a[0] - c[0] * lam, d1 = a[1] - c[1] * lam;
        float ss = (d0[0] * d0[0] + d0[1] * d0[1]) + (d0[2] * d0[2] + d0[3] * d0[3]) + (d1[0] * d1[0] + d1[1] * d1[1]) + (d1[2] * d1[2] + d1[3] * d1[3]);
#pragma unroll
        for (int o = 1; o < 16; o <<= 1) ss += __shfl_xor(ss, o);
        const float rs = rsqrtf(ss * (1.0f / 128.0f) + RMS_EPS) * oscale;
        d0 = d0 * rs * g0; d1 = d1 * rs * g1;
        u32x4 w; w.x = cvtpk(d0[0], d0[1]); w.y = cvtpk(d0[2], d0[3]); w.z = cvtpk(d1[0], d1[1]); w.w = cvtpk(d1[2], d1[3]);
        *((u32x4*)(CAT + (size_t)m * 1024) + lane) = w;
    }
}
__device__ __forceinline__ void transpose_item(const float* W, int K, int N, bf16_t* WT, LAS float* scr, int item, int lane) {
    const int nblk = N / 32, kb = item / nblk, nb = item % nblk, k0 = 64 * kb, n0 = 32 * nb;
#pragma unroll 8
    for (int i = 0; i < 32; ++i) { const int kk = 2 * i + (lane >> 5); scr[kk * 33 + (lane & 31)] = W[(size_t)(k0 + kk) * N + n0 + (lane & 31)]; }
    asm volatile("s_waitcnt lgkmcnt(0)" ::: "memory");
    const int c = lane & 7;
#pragma unroll
    for (int j = 0; j < 4; ++j) { const int n = (lane >> 3) + 8 * j; const LAS float* s = scr + (8 * c) * 33 + n;
        u32x4 o; o.x = cvtpk(s[0 * 33], s[1 * 33]); o.y = cvtpk(s[2 * 33], s[3 * 33]); o.z = cvtpk(s[4 * 33], s[5 * 33]); o.w = cvtpk(s[6 * 33], s[7 * 33]);
        *(u32x4*)(WT + (size_t)(n0 + n) * K + k0 + 8 * c) = o; }
    asm volatile("s_waitcnt lgkmcnt(0)" ::: "memory");
}

struct Args {
    const float* x; const float* g_pre_mix; const float* w_in; const float* lq1; const float* lk1; const float* lq2; const float* lk2;
    const float* subln; const float* relb; const float* gnb; const float* gnc; const float* w_out; const float* g_post_mix; const float* g_pre_mlp;
    const float* w_up; const float* w_down; const float* g_post_mlp;
    float* out; unsigned char* ws;
    float inv_freq[8]; float lam_init[2]; int ph_lo, ph_hi, coop, pad;
};
constexpr int NPHASE = 1 + 8 * NLAYER;
constexpr int LDS_BYTES = 147456;

__device__ __forceinline__ void convert_weights(const Args& a, int l, LAS unsigned char* lds, int gw, int NGW, int wave, int lane) {
    LAS float* scr = (LAS float*)(lds + wave * 16384);
    constexpr int I_IN = (DM / 64) * (DIN / 32), I_O = (DM / 64) * (DM / 32), I_U = (DM / 64) * (DFF / 32), I_D = (DFF / 64) * (DM / 32);
    constexpr int NITEMS = I_IN + I_O + I_U + I_D;
    bf16_t* Wi = (bf16_t*)(a.ws + WS_WI); bf16_t* Wo = (bf16_t*)(a.ws + WS_WO); bf16_t* Wu = (bf16_t*)(a.ws + WS_WU); bf16_t* Wd = (bf16_t*)(a.ws + WS_WD);
    for (int it = gw; it < NITEMS; it += NGW) {
        int r = it;
        if (r < I_IN) { transpose_item(a.w_in + (size_t)l * DM * DIN, DM, DIN, Wi, scr, r, lane); continue; } r -= I_IN;
        if (r < I_O) { transpose_item(a.w_out + (size_t)l * DM * DM, DM, DM, Wo, scr, r, lane); continue; } r -= I_O;
        if (r < I_U) { transpose_item(a.w_up + (size_t)l * DM * DFF, DM, DFF, Wu, scr, r, lane); continue; } r -= I_U;
        transpose_item(a.w_down + (size_t)l * DFF * DM, DFF, DM, Wd, scr, r, lane);
    }
}

__global__ void __launch_bounds__(512, 2) mk_fwd(Args a) {
    extern __shared__ __attribute__((aligned(16))) unsigned char lds_raw[];
    LAS unsigned char* lds = (LAS unsigned char*)lds_raw;
    cg::grid_group grid = cg::this_grid();
    const int G = gridDim.x, bx = blockIdx.x;
    const int vcu = (G % 8 == 0) ? (bx % 8) * (G / 8) + bx / 8 : bx;
    const int NGW = G * 8;
#define FRESH_IDS() const int tid = fresh_tid(), lane = tid & 63, wave = __builtin_amdgcn_readfirstlane(tid >> 6), gw = vcu * 8 + wave; (void)tid; (void)lane; (void)gw
    unsigned char* ws = a.ws;
    bf16_t* Wi = (bf16_t*)(ws + WS_WI); bf16_t* Wo = (bf16_t*)(ws + WS_WO); bf16_t* Wu = (bf16_t*)(ws + WS_WU); bf16_t* Wd = (bf16_t*)(ws + WS_WD);
    bf16_t* HN = (bf16_t*)(ws + WS_HN); float* Y = (float*)(ws + WS_Y); bf16_t* QK = (bf16_t*)(ws + WS_QK); bf16_t* U = (bf16_t*)(ws + WS_U);
    bf16_t* VTa = (bf16_t*)(ws + WS_VTA); bf16_t* VTb = (bf16_t*)(ws + WS_VTB); bf16_t* VTc = (bf16_t*)(ws + WS_VTC);
    float* OA = (float*)(ws + WS_OA); bf16_t* CAT = (bf16_t*)(ws + WS_CAT); float* rope = (float*)(ws + WS_ROPE);

    const int lo = a.ph_lo, hi = a.ph_hi;
#define IN(p) (lo <= (p) && (p) < hi)
#define SEAM(p) do { if (IN((p) + 1) && a.coop) grid.sync(); } while (0)
    if (IN(0)) {
        FRESH_IDS();
        convert_weights(a, 0, lds, gw, NGW, wave, lane);
        for (int p = bx * 512 + tid; p < SEQ; p += G * 512) {
            f32x4 c[2], s[2];
#pragma unroll
            for (int j = 0; j < 8; ++j) {
                const float ang = (float)p * a.inv_freq[j];
                double t = (double)ang * 0.15915494309189535; t -= rint(t);
                const float tf = (float)t;
                c[j >> 2][j & 3] = __builtin_amdgcn_cosf(tf); s[j >> 2][j & 3] = __builtin_amdgcn_sinf(tf);
            }
            f32x4* o = (f32x4*)(rope + (size_t)p * 16); o[0] = c[0]; o[1] = c[1]; o[2] = s[0]; o[3] = s[1];
        }
        prenorm_pass(a.x, a.g_pre_mix, HN, gw, NGW, lane);
        SEAM(0);
    }
    for (int l = 0; l < NLAYER; ++l) {
        const int p0 = 1 + 8 * l;
        if (IN(p0)) {
            pg8::Gemm g{HN, Wi, NTOK, DIN, DM}; pg8::StaticOrder S; S.init(NTOK, DIN, G, bx);
            pg8::EpiProj E{QK, VTa, rope};
            pg8::gemm_phase<pg8::EpiProj, pg8::StaticOrder, true, true>(lds, g, S, E);
            SEAM(p0);
        }
        if (IN(p0 + 1)) {
            const att::Lane L = att::make_lane();
            for (int it = vcu; it < 256; it += G) {
                const int combo = it >> 3, s = it & 7, b = combo >> 3, h = (combo >> 1) & 3, n = combo & 1;
                att::attnA_item(lds, L, QK, VTa, OA, b, h, n, 15 - s);
                att::attnA_item(lds, L, QK, VTa, OA, b, h, n, s);
            }
            for (int it = vcu; it < 256; it += G) {
                const int b = it >> 6, h = (it >> 4) & 3, qblk = it & 15;
                att::attnB_item(lds, L, QK, VTb, CAT, a.relb + (size_t)l * 4 * 257, a.gnb + l * 256, b, h, qblk);
            }
            for (int it = vcu; it < 256; it += G) {
                const int b = it >> 6, h = (it >> 4) & 3, qblk = it & 15;
                att::attnC_item(lds, L, QK, VTc, CAT, a.gnc + l * 256, b, h, qblk);
            }
            SEAM(p0 + 1);
        }
        if (IN(p0 + 2)) {
            FRESH_IDS();
            const float li = (l == 0) ? a.lam_init[0] : a.lam_init[1];
            const float s1 = wave_sum(a.lq1[l * 64 + lane] * a.lk1[l * 64 + lane]), s2 = wave_sum(a.lq2[l * 64 + lane] * a.lk2[l * 64 + lane]);
            const float lam = expf(s1) - expf(s2) + li;
            combine_pass(OA, CAT, a.subln + l * 128, lam, 1.0f - li, gw, NGW, lane);
            SEAM(p0 + 2);
        }
        if (IN(p0 + 3)) {
            pg8::Gemm g{CAT, Wo, NTOK, DM, DM}; pg8::StaticOrder S; S.init(NTOK, DM, G, bx);
            pg8::EpiF32 E{Y, DM};
            pg8::gemm_phase<pg8::EpiF32, pg8::StaticOrder, true, true>(lds, g, S, E);
            SEAM(p0 + 3);
        }
        if (IN(p0 + 4)) {
            FRESH_IDS();
            postnorm_pass(Y, l == 0 ? a.x : a.out, a.out, a.g_post_mix + l * DM, a.g_pre_mlp + l * DM, HN, gw, NGW, lane);
            SEAM(p0 + 4);
        }
        if (IN(p0 + 5)) {
            pg8::Gemm g{HN, Wu, NTOK, DFF, DM}; pg8::StaticOrder S; S.init(NTOK, DFF, G, bx);
            pg8::EpiRelu2 E{U, DFF};
            pg8::gemm_phase<pg8::EpiRelu2, pg8::StaticOrder, true, true>(lds, g, S, E);
            SEAM(p0 + 5);
        }
        if (IN(p0 + 6)) {
            pg8::Gemm g{U, Wd, NTOK, DM, DFF}; pg8::StaticOrder S; S.init(NTOK, DM, G, bx);
            pg8::EpiF32 E{Y, DM};
            pg8::gemm_phase<pg8::EpiF32, pg8::StaticOrder, true, true>(lds, g, S, E);
            SEAM(p0 + 6);
        }
        if (IN(p0 + 7)) {
            FRESH_IDS();
            postnorm_pass(Y, a.out, a.out, a.g_post_mlp + l * DM, (l + 1 < NLAYER) ? a.g_pre_mix + (l + 1) * DM : nullptr, HN, gw, NGW, lane);
            if (l + 1 < NLAYER) convert_weights(a, l + 1, lds, gw, NGW, wave, lane);
            SEAM(p0 + 7);
        }
    }
#undef IN
#undef SEAM
}

extern "C" void kernel_launch(void* const* d_in, const int* in_sizes, int n_in, void* d_out, int out_size, void* d_ws, size_t ws_size, hipStream_t stream) {
    static int grid_blocks = 0;
    if (grid_blocks == 0) {
        if (n_in != 17 || ws_size < WS_END) { fprintf(stderr, "kernel_launch: unexpected inputs (n_in %d, ws %zu)\n", n_in, ws_size); grid_blocks = -1; return; }
        int dev = 0, cus = 0, per_cu = 0;
        hipGetDevice(&dev);
        hipDeviceGetAttribute(&cus, hipDeviceAttributeMultiprocessorCount, dev);
        if (hipFuncSetAttribute((const void*)mk_fwd, hipFuncAttributeMaxDynamicSharedMemorySize, LDS_BYTES) != hipSuccess) fprintf(stderr, "kernel_launch: hipFuncSetAttribute failed\n");
        if (hipOccupancyMaxActiveBlocksPerMultiprocessor(&per_cu, (const void*)mk_fwd, 512, LDS_BYTES) != hipSuccess || per_cu < 1) { fprintf(stderr, "kernel_launch: occupancy query gave %d\n", per_cu); per_cu = 1; }
        (void)hipGetLastError();
        grid_blocks = cus * per_cu;
        if (grid_blocks % 8 != 0 || grid_blocks > 1024) grid_blocks = cus;
    }
    if (grid_blocks < 0) return;
    Args a{};
    a.x = (const float*)d_in[0]; a.g_pre_mix = (const float*)d_in[1]; a.w_in = (const float*)d_in[2]; a.lq1 = (const float*)d_in[3]; a.lk1 = (const float*)d_in[4];
    a.lq2 = (const float*)d_in[5]; a.lk2 = (const float*)d_in[6]; a.subln = (const float*)d_in[7]; a.relb = (const float*)d_in[8]; a.gnb = (const float*)d_in[9];
    a.gnc = (const float*)d_in[10]; a.w_out = (const float*)d_in[11]; a.g_post_mix = (const float*)d_in[12]; a.g_pre_mlp = (const float*)d_in[13];
    a.w_up = (const float*)d_in[14]; a.w_down = (const float*)d_in[15]; a.g_post_mlp = (const float*)d_in[16];
    a.out = (float*)d_out; a.ws = (unsigned char*)d_ws;
    for (int j = 0; j < 8; ++j) a.inv_freq[j] = powf(500000.0f, -(float)(2 * j) / 16.0f);
    for (int l = 0; l < 2; ++l) a.lam_init[l] = (float)(0.8 - 0.6 * exp(-0.3 * (double)l));
    a.pad = 0;
#if MK_SPLIT
    a.coop = 0;
    for (int ph = 0; ph < NPHASE; ++ph) { a.ph_lo = ph; a.ph_hi = ph + 1; hipLaunchKernelGGL(mk_fwd, dim3(grid_blocks), dim3(512), LDS_BYTES, stream, a); }
#else
    a.coop = 1; a.ph_lo = 0; a.ph_hi = NPHASE;
    void* args[] = {&a};
    hipError_t e = hipLaunchCooperativeKernel((const void*)mk_fwd, dim3(grid_blocks), dim3(512), args, LDS_BYTES, stream);
    if (e != hipSuccess) fprintf(stderr, "cooperative launch failed: %s (grid %d)\n", hipGetErrorString(e), grid_blocks);
#endif
}
```

```cpp
#include <hip/hip_runtime.h>
#include <hip/hip_cooperative_groups.h>
#include <cstdio>
#include <cstdint>
#include <cmath>
namespace cg = cooperative_groups;
#ifndef MK_SPLIT
#define MK_SPLIT 0
#endif

#ifndef PROBE_REP_A
#define PROBE_REP_A 1
#endif
#ifndef PROBE_REP_B
#define PROBE_REP_B 1
#endif
#ifndef PROBE_REP_C
#define PROBE_REP_C 1
#endif
constexpr int SEQ = 4096, NBATCH = 4, DM = 1024, DFF = 4096, DIN = 3072, NTOK = NBATCH * SEQ, NLAYER = 2;
constexpr int QKP = 2048;
constexpr size_t VTB_OFF = (size_t)8 << 20, VTC_OFF = (size_t)12 << 20;
constexpr float RMS_EPS = 1e-6f;
constexpr float LOG2E = 1.4426950408889634f;
constexpr float QSCALE = 0.125f * LOG2E;

#define LAS __attribute__((address_space(3)))
__device__ __forceinline__ int fresh_tid() { int t = threadIdx.x; asm volatile("" : "+v"(t)); return t; }

namespace pg8 {
#define PG8_LAS __attribute__((address_space(3)))
typedef unsigned short bf16_t;
typedef short bf16x8 __attribute__((ext_vector_type(8)));
typedef float f32x4 __attribute__((ext_vector_type(4)));
typedef unsigned u32x4 __attribute__((ext_vector_type(4)));
constexpr int BM = 256, BK = 64, HALF = 128, HTB = HALF * BK * 2  , STAGE_BYTES = 8 * HTB, NXCD = 8, WGM = 8;

__host__ __device__ __forceinline__ int lds_byte(int r, int c) { const int st = (r >> 4) * 2 + (c >> 5), rr = r & 15, cc = c & 31, ob = rr * 64 + cc * 2; return st * 1024 + (ob ^ (((ob >> 9) & 1) << 5)); }
__host__ __device__ __forceinline__ void stage_rc(int b, int& R, int& C) { const int st = b / 1024, sb = b % 1024, swz = sb ^ (((sb >> 9) & 1) << 5); R = (st >> 1) * 16 + swz / 64; C = (st & 1) * 32 + (swz % 64) / 2; }
__host__ __device__ __forceinline__ int perm32(int rho) { const int n = rho >> 4, i = rho & 15; return 8 * (i >> 2) + 4 * n + (i & 3); }

struct Unit { int pm, pn; };
struct Gemm { const bf16_t* A; const bf16_t* Bt; int M, N, K; };

struct StaticOrder {
    int nM, nN, nwg, G, c;
    __host__ __device__ void init(int M, int N, int G_, int c_) { nM = M / BM; nN = N / BM; nwg = nM * nN; G = G_; c = c_; }
    __host__ __device__ bool next(int i, Unit& u) const {
        const long L = (long)i * G + c; if (L >= nwg) return false;
        int wgid = (int)L; { const int q = nwg / NXCD, r = nwg % NXCD, xcd = wgid % NXCD, off = wgid / NXCD; wgid = (xcd < r ? xcd * (q + 1) : r * (q + 1) + (xcd - r) * q) + off; }
        const int nig = WGM * nN, gid = wgid / nig, fm = gid * WGM, gsz = (nM - fm) < WGM ? (nM - fm) : WGM;
        u.pm = fm + ((wgid % nig) % gsz); u.pn = (wgid % nig) / gsz; return true;
    }
    __device__ __forceinline__ void a_ready(const Unit&) const {}
    __device__ __forceinline__ void done(const Unit&) const {}
};

__device__ __forceinline__ unsigned cvt_pk_bf16(float lo, float hi) { unsigned r; asm volatile("v_cvt_pk_bf16_f32 %0, %1, %2" : "=v"(r) : "v"(lo), "v"(hi)); return r; }
typedef float f32x2 __attribute__((ext_vector_type(2)));
typedef float f32x2 __attribute__((ext_vector_type(2)));
typedef __bf16 bf16x2_t __attribute__((ext_vector_type(2)));
__device__ __forceinline__ unsigned cvtpk(float lo, float hi) { f32x2 v = {lo, hi}; bf16x2_t b = __builtin_convertvector(v, bf16x2_t); return __builtin_bit_cast(unsigned, b); }
__device__ __forceinline__ bf16_t cvt1(float v) { return (bf16_t)(cvtpk(v, 0.f) & 0xffffu); }

struct EpiProj {
    static constexpr bool PERM = true, AFTER_DRAIN = false;
    bf16_t* QK; bf16_t* VT; const float* rope;
    __device__ __forceinline__ void operator()(const f32x4 (&acc)[2][2][4][2], const Unit& u, int wr, int wc, int fr, int fq) const {
        const int pn = u.pn;
        const int row0 = u.pm * BM + wr * 64 + fr;
        const int cin = wc * 32 + 8 * fq;
        if (pn == 4 || pn == 5 || pn == 8 || pn == 11) {
            const size_t voff = (pn <= 5) ? (size_t)0 : (pn == 8 ? VTB_OFF : VTC_OFF);
            bf16_t* base = VT + voff;
            const int nd = (pn <= 5) ? 128 : 64, c0 = (pn == 5) ? 256 : 0;
#pragma unroll
            for (int ai = 0; ai < 2; ++ai)
#pragma unroll
                for (int m = 0; m < 4; ++m) {
                    const int row = row0 + ai * HALF + m * 16, b = row >> 12, s = row & (SEQ - 1);
#pragma unroll
                    for (int bj = 0; bj < 2; ++bj) {
                        const int c = c0 + bj * HALF + cin;
                        const int h = c / nd, e = c % nd;
                        bf16_t* p = base + ((size_t)((b * 4 + h) * nd + e)) * SEQ + s;
#pragma unroll
                        for (int n = 0; n < 2; ++n)
#pragma unroll
                            for (int i = 0; i < 4; ++i) p[(size_t)(4 * n + i) * SEQ] = cvt1(acc[ai][bj][m][n][i]);
                    }
                }
            return;
        }
        int dcol; bool rope_on = false; float sc = 1.f;
        if (pn <= 1) { dcol = pn * 256; rope_on = true; sc = QSCALE; }
        else if (pn <= 3) { dcol = 512 + (pn - 2) * 256; rope_on = true; }
        else if (pn == 6) { dcol = 1024; sc = QSCALE; }
        else if (pn == 7) { dcol = 1280; }
        else if (pn == 9) { dcol = 1536; sc = QSCALE; }
        else { dcol = 1792; }
        const bool rl = ((wc & 1) == 0) && (fq < 2);
#pragma unroll
        for (int ai = 0; ai < 2; ++ai)
#pragma unroll
            for (int m = 0; m < 4; ++m) {
                const int row = row0 + ai * HALF + m * 16;
#pragma unroll
                for (int bj = 0; bj < 2; ++bj) {
                    f32x4 v0 = acc[ai][bj][m][0], v1 = acc[ai][bj][m][1];
                    if (rope_on) {
                        f32x4 o0, o1;
#pragma unroll
                        for (int i = 0; i < 4; ++i) { o0[i] = __shfl_xor(v0[i], 16); o1[i] = __shfl_xor(v1[i], 16); }
                        if (rl) {
                            const f32x4* t = (const f32x4*)(rope + (size_t)(row & (SEQ - 1)) * 16);
                            const f32x4 c0 = t[0], c1 = t[1], s0 = t[2], s1 = t[3];
                            if (fq == 0) { v0 = v0 * c0 - o0 * s0; v1 = v1 * c1 - o1 * s1; }
                            else         { v0 = v0 * c0 + o0 * s0; v1 = v1 * c1 + o1 * s1; }
                        }
                    }
                    v0 = v0 * sc; v1 = v1 * sc;
                    u32x4 w; w.x = cvtpk(v0[0], v0[1]); w.y = cvtpk(v0[2], v0[3]); w.z = cvtpk(v1[0], v1[1]); w.w = cvtpk(v1[2], v1[3]);
                    *(u32x4*)(QK + (size_t)row * QKP + dcol + bj * HALF + cin) = w;
                }
            }
    }
};
struct EpiF32 {
    static constexpr bool PERM = true, AFTER_DRAIN = false;
    float* O; int ldc;
    __device__ __forceinline__ void operator()(const f32x4 (&acc)[2][2][4][2], const Unit& u, int wr, int wc, int fr, int fq) const {
        const int row0 = u.pm * BM + wr * 64 + fr, col0 = u.pn * BM + wc * 32 + 8 * fq;
#pragma unroll
        for (int ai = 0; ai < 2; ++ai)
#pragma unroll
            for (int m = 0; m < 4; ++m) { float* rowp = O + (size_t)(row0 + ai * HALF + m * 16) * ldc + col0;
#pragma unroll
                for (int bj = 0; bj < 2; ++bj) { *(f32x4*)(rowp + bj * HALF) = acc[ai][bj][m][0]; *(f32x4*)(rowp + bj * HALF + 4) = acc[ai][bj][m][1]; } }
    }
};
struct EpiRelu2 {
    static constexpr bool PERM = true, AFTER_DRAIN = false;
    bf16_t* O; int ldc;
    __device__ __forceinline__ void operator()(const f32x4 (&acc)[2][2][4][2], const Unit& u, int wr, int wc, int fr, int fq) const {
        const int row0 = u.pm * BM + wr * 64 + fr, col0 = u.pn * BM + wc * 32 + 8 * fq;
#pragma unroll
        for (int ai = 0; ai < 2; ++ai)
#pragma unroll
            for (int m = 0; m < 4; ++m) { bf16_t* rowp = O + (size_t)(row0 + ai * HALF + m * 16) * ldc + col0;
#pragma unroll
                for (int bj = 0; bj < 2; ++bj) { f32x4 v0 = acc[ai][bj][m][0], v1 = acc[ai][bj][m][1];
#pragma unroll
                    for (int i = 0; i < 4; ++i) { const float a = fmaxf(v0[i], 0.f), b = fmaxf(v1[i], 0.f); v0[i] = a * a; v1[i] = b * b; }
                    u32x4 w; w.x = cvtpk(v0[0], v0[1]); w.y = cvtpk(v0[2], v0[3]); w.z = cvtpk(v1[0], v1[1]); w.w = cvtpk(v1[2], v1[3]);
                    *(u32x4*)(rowp + bj * HALF) = w; } }
    }
};

template <class Epi, class Sched, bool ALIGN_EPI = false, bool SP2 = false>
__device__ __forceinline__ void gemm_phase(PG8_LAS unsigned char* lds, const Gemm g, const Sched& S, const Epi& E) {
    const int tid = fresh_tid(), wid = __builtin_amdgcn_readfirstlane(tid >> 6), lane = tid & 63, wr = wid >> 2, wc = wid & 3, fr = lane & 15, fq = lane >> 4;
    const int K = g.K, nt = K / BK;
    unsigned voffA[2], voffB[2];
#pragma unroll
    for (int i = 0; i < 2; ++i) { int R, C; stage_rc(tid * 16 + i * 8192, R, C); const int Rb = Epi::PERM ? ((R & ~31) + perm32(R & 31)) : R;
        voffA[i] = (unsigned)(R * K + C) * 2u; voffB[i] = (unsigned)(Rb * K + C) * 2u; }
    const size_t kstep = (size_t)(BK * 2);
    const size_t hstep = (size_t)HALF * K * 2;
    const size_t tstep = 2 * hstep;
    const unsigned ldsw = (unsigned)wid * 1024u;
    const int aoff = lds_byte(wr * 64 + fr, fq * 8), boff = lds_byte(wc * 32 + fr, fq * 8);
#define PG8_SA(b, h) (((b) * 2 + (h)) * HTB)
#define PG8_SB(b, h) ((4 + (b) * 2 + (h)) * HTB)
#define PG8_STAGE(bufoff, gbase, voff) do { _Pragma("unroll") for (int _i = 0; _i < 2; ++_i) \
        __builtin_amdgcn_global_load_lds((const unsigned*)((const char*)(gbase) + (voff)[_i]), (PG8_LAS unsigned*)(lds + (bufoff) + ldsw + _i * 8192), 16, 0, 0); } while (0)
#define PG8_LDA(dst, b, h) do { _Pragma("unroll") for (int m = 0; m < 4; ++m) _Pragma("unroll") for (int k = 0; k < 2; ++k) dst[m][k] = *(const PG8_LAS bf16x8*)(lds + PG8_SA(b, h) + aoff + m * 2048 + k * 1024); } while (0)
#define PG8_LDB(dst, b, h) do { _Pragma("unroll") for (int n = 0; n < 2; ++n) _Pragma("unroll") for (int k = 0; k < 2; ++k) dst[n][k] = *(const PG8_LAS bf16x8*)(lds + PG8_SB(b, h) + boff + n * 2048 + k * 1024); } while (0)
#define PG8_MMA(ai, bj, At, Bt) do { __builtin_amdgcn_s_setprio(1); _Pragma("unroll") for (int m = 0; m < 4; ++m) _Pragma("unroll") for (int n = 0; n < 2; ++n) _Pragma("unroll") for (int k = 0; k < 2; ++k) \
        acc[ai][bj][m][n] = __builtin_amdgcn_mfma_f32_16x16x32_bf16(Bt[n][k], At[m][k], acc[ai][bj][m][n], 0, 0, 0); __builtin_amdgcn_s_setprio(0); } while (0)
#define PG8_WAIT_V(n) asm volatile("s_waitcnt vmcnt(" #n ")" ::: "memory")
#define PG8_WAIT_L(n) asm volatile("s_waitcnt lgkmcnt(" #n ")" ::: "memory")
#define PG8_BAR __builtin_amdgcn_s_barrier()
#define PG8_SCHED __builtin_amdgcn_sched_barrier(0)
    Unit cur, nxt; int ui = 0;
    if (!S.next(0, cur)) return;
    f32x4 acc[2][2][4][2];
#pragma unroll
    for (int a = 0; a < 2; ++a)
#pragma unroll
        for (int b = 0; b < 2; ++b)
#pragma unroll
            for (int m = 0; m < 4; ++m)
#pragma unroll
                for (int n = 0; n < 2; ++n) acc[a][b][m][n] = (f32x4){0.f, 0.f, 0.f, 0.f};
    bf16x8 At[4][2], B0[2][2], B1[2][2];
    const char* cA = (const char*)g.A + (size_t)cur.pm * tstep; const char* cB = (const char*)g.Bt + (size_t)cur.pn * tstep;
    S.a_ready(cur);
    if constexpr (SP2) {
        PG8_STAGE(PG8_SB(0, 0), cB, voffB); PG8_STAGE(PG8_SB(0, 1), cB + hstep, voffB); PG8_STAGE(PG8_SA(0, 0), cA, voffA); PG8_STAGE(PG8_SA(0, 1), cA + hstep, voffA);
        if (wr == 1) PG8_BAR;
        PG8_WAIT_V(2); PG8_BAR;
        PG8_STAGE(PG8_SB(1, 0), cB + kstep, voffB); PG8_STAGE(PG8_SA(1, 0), cA + kstep, voffA); PG8_STAGE(PG8_SB(1, 1), cB + hstep + kstep, voffB);
        PG8_WAIT_V(6); PG8_BAR;
    } else {
        PG8_STAGE(PG8_SB(0, 0), cB, voffB); PG8_STAGE(PG8_SA(0, 0), cA, voffA); PG8_STAGE(PG8_SB(0, 1), cB + hstep, voffB); PG8_STAGE(PG8_SA(0, 1), cA + hstep, voffA);
        if (wr == 1) PG8_BAR;
        PG8_WAIT_V(4); PG8_BAR;
        PG8_STAGE(PG8_SB(1, 0), cB + kstep, voffB); PG8_STAGE(PG8_SA(1, 0), cA + kstep, voffA); PG8_STAGE(PG8_SB(1, 1), cB + hstep + kstep, voffB);
        PG8_WAIT_V(6); PG8_BAR;
    }
    for (;;) {
        const bool has_next = S.next(ui + 1, nxt);
        const char* nA = has_next ? (const char*)g.A + (size_t)nxt.pm * tstep : cA; const char* nB = has_next ? (const char*)g.Bt + (size_t)nxt.pn * tstep : cB;
        for (int t = 0; t < nt; t += 2) {
            const bool last = (t == nt - 2);
            const char* a1 = cA + (size_t)(t + 1) * kstep;
            const char* a2 = last ? nA : cA + (size_t)(t + 2) * kstep; const char* b2 = last ? nB : cB + (size_t)(t + 2) * kstep;
            const char* a3 = a2 + kstep; const char* b3 = b2 + kstep;
            if (last && has_next) S.a_ready(nxt);
            if constexpr (SP2) {
            PG8_LDB(B0, 0, 0); PG8_LDB(B1, 0, 1); PG8_SCHED; PG8_LDA(At, 0, 0); PG8_STAGE(PG8_SA(1, 1), a1 + hstep, voffA);
            PG8_WAIT_V(8); PG8_WAIT_L(0); PG8_BAR; PG8_MMA(0, 0, At, B0); PG8_MMA(0, 1, At, B1); PG8_BAR; PG8_SCHED;
            PG8_LDA(At, 0, 1); PG8_STAGE(PG8_SB(0, 0), b2, voffB); PG8_STAGE(PG8_SB(0, 1), b2 + hstep, voffB); PG8_STAGE(PG8_SA(0, 0), a2, voffA);
            PG8_WAIT_V(8); PG8_WAIT_L(0); PG8_BAR; PG8_MMA(1, 0, At, B0); PG8_MMA(1, 1, At, B1); PG8_BAR; PG8_SCHED;
            PG8_LDB(B0, 1, 0); PG8_LDB(B1, 1, 1); PG8_SCHED; PG8_LDA(At, 1, 0); PG8_STAGE(PG8_SA(0, 1), a2 + hstep, voffA);
            PG8_WAIT_V(8); PG8_WAIT_L(0); PG8_BAR; PG8_MMA(0, 0, At, B0); PG8_MMA(0, 1, At, B1); PG8_BAR; PG8_SCHED;
            PG8_LDA(At, 1, 1); PG8_STAGE(PG8_SB(1, 0), b3, voffB); PG8_STAGE(PG8_SB(1, 1), b3 + hstep, voffB); PG8_STAGE(PG8_SA(1, 0), a3, voffA);
            PG8_WAIT_V(8); PG8_WAIT_L(0); PG8_BAR; PG8_MMA(1, 0, At, B0); PG8_MMA(1, 1, At, B1); PG8_BAR; PG8_SCHED;
            } else {
            PG8_LDB(B0, 0, 0); PG8_SCHED; PG8_LDA(At, 0, 0); PG8_STAGE(PG8_SA(1, 1), a1 + hstep, voffA);
            PG8_WAIT_L(8); PG8_BAR; PG8_WAIT_L(0); PG8_MMA(0, 0, At, B0); PG8_BAR; PG8_SCHED;
            PG8_LDB(B1, 0, 1); PG8_STAGE(PG8_SB(0, 0), b2, voffB);
            PG8_BAR; PG8_WAIT_L(0); PG8_MMA(0, 1, At, B1); PG8_BAR;
            PG8_LDA(At, 0, 1); PG8_STAGE(PG8_SA(0, 0), a2, voffA);
            PG8_BAR; PG8_WAIT_L(0); PG8_MMA(1, 0, At, B0); PG8_BAR; PG8_SCHED;
            PG8_STAGE(PG8_SB(0, 1), b2 + hstep, voffB);
            PG8_WAIT_V(6); PG8_BAR; PG8_MMA(1, 1, At, B1); PG8_BAR;
            PG8_LDB(B0, 1, 0); PG8_SCHED; PG8_LDA(At, 1, 0); PG8_STAGE(PG8_SA(0, 1), a2 + hstep, voffA);
            PG8_WAIT_L(8); PG8_BAR; PG8_WAIT_L(0); PG8_MMA(0, 0, At, B0); PG8_BAR; PG8_SCHED;
            PG8_LDB(B1, 1, 1); PG8_STAGE(PG8_SB(1, 0), b3, voffB);
            PG8_BAR; PG8_WAIT_L(0); PG8_MMA(0, 1, At, B1); PG8_BAR;
            PG8_LDA(At, 1, 1); PG8_STAGE(PG8_SA(1, 0), a3, voffA);
            PG8_BAR; PG8_WAIT_L(0); PG8_MMA(1, 0, At, B0); PG8_BAR; PG8_SCHED;
            PG8_STAGE(PG8_SB(1, 1), b3 + hstep, voffB);
            PG8_WAIT_V(6); PG8_BAR; PG8_MMA(1, 1, At, B1); PG8_BAR;
            }
        }
        if constexpr (ALIGN_EPI) { if (wr == 0) PG8_BAR; }
        if constexpr (!Epi::AFTER_DRAIN) { E(acc, cur, wr, wc, fr, fq); S.done(cur); }
        if (!has_next) break;
#pragma unroll
        for (int a = 0; a < 2; ++a)
#pragma unroll
            for (int b = 0; b < 2; ++b)
#pragma unroll
                for (int m = 0; m < 4; ++m)
#pragma unroll
                    for (int n = 0; n < 2; ++n) acc[a][b][m][n] = (f32x4){0.f, 0.f, 0.f, 0.f};
        cur = nxt; cA = nA; cB = nB; ++ui;
        if constexpr (ALIGN_EPI) { if (wr == 1) PG8_BAR; }
    }
    PG8_WAIT_V(0);
    if constexpr (!ALIGN_EPI) { if (wr == 0) PG8_BAR; }
    PG8_BAR;
    if constexpr (Epi::AFTER_DRAIN) { E.fused(acc, cur, wr, wc, fr, fq, lds, wid, lane); S.done(cur); }
#undef PG8_SA
#undef PG8_SB
#undef PG8_STAGE
#undef PG8_LDA
#undef PG8_LDB
#undef PG8_MMA
#undef PG8_WAIT_V
#undef PG8_WAIT_L
#undef PG8_BAR
#undef PG8_SCHED
}
}
#define XB_TMO      128
#define XB_XCNT(j)  (256  + 64 * (j))
#define XB_XSUB(j)  (1280 + 64 * (j))
#define XB_XGEN(j)  (2304 + 64 * (j))
#define XB_TOP      3328
#define XB_TOPGEN   3392
#define XCD_BAR_WORDS 3456
#define XB_SPIN_CAP (1u << 18)

__device__ __forceinline__ unsigned xb_ld(unsigned* p)              { return __hip_atomic_load(p, __ATOMIC_RELAXED, __HIP_MEMORY_SCOPE_AGENT); }
__device__ __forceinline__ unsigned xb_add(unsigned* p, unsigned v) { return __hip_atomic_fetch_add(p, v, __ATOMIC_RELAXED, __HIP_MEMORY_SCOPE_AGENT); }
__device__ __forceinline__ unsigned xb_xcc_id() { return (unsigned)__builtin_amdgcn_s_getreg((3 << 11) | 20) & 0xFu; }
#define XB_SPIN(cond, bar) do { unsigned _sp = 0; while (cond) { __builtin_amdgcn_s_sleep(1); \
    if ((++_sp & 255u) == 0u) { if (xb_ld(&(bar)[XB_TMO])) break; if (_sp > XB_SPIN_CAP) { atomicAdd(&(bar)[XB_TMO], 1u); break; } } } } while (0)

struct XcdBarrier {
    unsigned* bar; unsigned x;
    volatile LAS unsigned* st;
};

__device__ __forceinline__ XcdBarrier xcd_barrier_post(unsigned* bar, volatile LAS unsigned* st) {
    XcdBarrier b; b.bar = bar; b.x = xb_xcc_id(); b.st = st;
    if (threadIdx.x == 0) (void)xb_add(&bar[XB_XCNT(b.x)], 1u);
    return b;
}
__device__ __forceinline__ void xcd_barrier_complete(unsigned* bar, unsigned x, unsigned& nloc, unsigned& nx) {
    const unsigned G = gridDim.x * gridDim.y * gridDim.z;
    unsigned sum, cnt, mine, sp = 0u;
    for (;;) {
        sum = 0u; cnt = 0u; mine = 0u;
#pragma unroll
        for (unsigned j = 0; j < 16; ++j) { const unsigned c = xb_ld(&bar[XB_XCNT(j)]); sum += c; cnt += (c > 0u) ? 1u : 0u; mine = (j == x) ? c : mine; }
        if (sum == G) break;
        __builtin_amdgcn_s_sleep(1);
        if ((++sp & 255u) == 0u) { if (xb_ld(&bar[XB_TMO])) break; if (sp > XB_SPIN_CAP) { atomicAdd(&bar[XB_TMO], 1u); break; } }
    }
    nloc = mine > 0u ? mine : 1u; nx = cnt > 0u ? cnt : 1u;
}

__device__ __forceinline__ void xcd_barrier(const XcdBarrier& b) {
    asm volatile("s_waitcnt vmcnt(0)" ::: "memory");
    __syncthreads();
    if (threadIdx.x == 0) {
        unsigned* bar = b.bar;
        __builtin_amdgcn_s_waitcnt(0);
        unsigned nloc = b.st[0], nx = b.st[1];
        if (nloc == 0u) { xcd_barrier_complete(bar, b.x, nloc, nx); b.st[0] = nloc; b.st[1] = nx; }
        const unsigned old = xb_add(&bar[XB_XSUB(b.x)], 1u);
        const unsigned gen = old / nloc;
        if (old + 1u == (gen + 1u) * nloc) {
            __builtin_amdgcn_fence(__ATOMIC_RELEASE, "agent");
            asm volatile("s_waitcnt vmcnt(0)" ::: "memory");
            const unsigned og = xb_add(&bar[XB_TOP], 1u);
            const unsigned tg = og / nx;
            if (og + 1u == (tg + 1u) * nx) xb_add(&bar[XB_TOPGEN], 1u);
            else XB_SPIN(xb_ld(&bar[XB_TOPGEN]) == tg, bar);
            __builtin_amdgcn_fence(__ATOMIC_ACQUIRE, "agent");
            xb_add(&bar[XB_XGEN(b.x)], 1u);
            asm volatile("s_waitcnt vmcnt(0)" ::: "memory");
        } else {
            XB_SPIN(xb_ld(&bar[XB_XGEN(b.x)]) == gen, bar);
            __builtin_amdgcn_fence(__ATOMIC_ACQUIRE, "agent");
            asm volatile("s_waitcnt vmcnt(0)" ::: "memory");
        }
    }
    __syncthreads();
}

typedef unsigned short bf16_t;
typedef short bf16x8 __attribute__((ext_vector_type(8)));
typedef float f32x4 __attribute__((ext_vector_type(4)));
typedef float f32x16 __attribute__((ext_vector_type(16)));
typedef unsigned u32x4 __attribute__((ext_vector_type(4)));
typedef unsigned u32x2 __attribute__((ext_vector_type(2)));
using pg8::cvtpk;
#define MFMA32(a, b, c) __builtin_amdgcn_mfma_f32_32x32x16_bf16((a), (b), (c), 0, 0, 0)
__device__ __forceinline__ float wave_sum(float v) {
#pragma unroll
    for (int o = 1; o < 64; o <<= 1) v += __shfl_xor(v, o);
    return v;
}
__device__ __forceinline__ float ex2(float x) { return __builtin_amdgcn_exp2f(x); }
__device__ __forceinline__ float lg2(float x) { return __builtin_amdgcn_logf(x); }

constexpr size_t MiB = 1u << 20;
constexpr size_t WS_ROPE = 1 * MiB;
constexpr size_t WS_WI = 2 * MiB, WS_WO = 8 * MiB, WS_WU = 10 * MiB, WS_WD = 18 * MiB;
constexpr size_t WS_HN = 26 * MiB;
constexpr size_t WS_Y = 58 * MiB;
constexpr size_t WS_QK = 58 * MiB;
constexpr size_t WS_U = 122 * MiB;
constexpr size_t WS_VTA = 122 * MiB, WS_VTB = 138 * MiB, WS_VTC = 146 * MiB;
constexpr size_t WS_OA = 154 * MiB;
constexpr size_t WS_CAT = 218 * MiB;
constexpr size_t WS_END = 250 * MiB;
static_assert(WS_VTB - WS_VTA == VTB_OFF * 2 && WS_VTC - WS_VTA == VTC_OFF * 2, "V^T offsets");

namespace att {
constexpr int KROW = 144;
constexpr int KBUF = 64 * KROW, VBUF = 128 * KROW;
constexpr int L_K0 = 0, L_K1 = KBUF, L_V0 = 2 * KBUF, L_V1 = 2 * KBUF + VBUF, L_MISC = 2 * KBUF + 2 * VBUF;
constexpr int L_RB = L_MISC, L_FLAG = L_MISC + 2048;

template <int DV> struct TileRegs { u32x4 k; u32x4 v[DV / 64]; };
template <int DV> __device__ __forceinline__ void tile_load(TileRegs<DV>& r, const bf16_t* Kb, const bf16_t* Vb, int key0, int tid) {
    const int row = tid >> 3, ch = tid & 7;
    r.k = *(const u32x4*)(Kb + (size_t)(key0 + row) * QKP + ch * 8);
#pragma unroll
    for (int i = 0; i < DV / 64; ++i) r.v[i] = *(const u32x4*)(Vb + (size_t)(row + 64 * i) * SEQ + key0 + ch * 8);
}
template <int DV> __device__ __forceinline__ void tile_store(const TileRegs<DV>& r, LAS unsigned char* lds, int kbuf, int vbuf, int tid) {
    const int row = tid >> 3, ch = tid & 7;
    *(LAS u32x4*)(lds + kbuf + row * KROW + ch * 16) = r.k;
#pragma unroll
    for (int i = 0; i < DV / 64; ++i) *(LAS u32x4*)(lds + vbuf + (row + 64 * i) * KROW + ch * 16) = r.v[i];
}
__device__ __forceinline__ void qk_tile(f32x16& s0, f32x16& s1, LAS const unsigned char* kp, const bf16x8 (&q)[4]) {
#pragma unroll
    for (int i = 0; i < 16; ++i) { s0[i] = 0.f; s1[i] = 0.f; }
#pragma unroll
    for (int d0 = 0; d0 < 4; ++d0) {
        const bf16x8 a0 = *(LAS const bf16x8*)(kp + d0 * 32), a1 = *(LAS const bf16x8*)(kp + 32 * KROW + d0 * 32);
        s0 = MFMA32(a0, q[d0], s0); s1 = MFMA32(a1, q[d0], s1);
    }
}
__device__ __forceinline__ bf16x8 pack8(const f32x16& s, int b) {
    u32x4 w; w.x = cvtpk(s[b], s[b + 1]); w.y = cvtpk(s[b + 2], s[b + 3]); w.z = cvtpk(s[b + 4], s[b + 5]); w.w = cvtpk(s[b + 6], s[b + 7]);
    return __builtin_bit_cast(bf16x8, w);
}
template <int NDB> __device__ __forceinline__ void pv_tile(f32x16 (&o)[NDB], LAS const unsigned char* vp, const bf16x8 (&pf)[4]) {
#pragma unroll
    for (int db = 0; db < NDB; ++db)
#pragma unroll
        for (int kg = 0; kg < 4; ++kg) { const bf16x8 a = *(LAS const bf16x8*)(vp + db * 32 * KROW + kg * 32); o[db] = MFMA32(a, pf[kg], o[db]); }
}
template <int NDB> __device__ __forceinline__ void softmax_update(f32x16& s0, f32x16& s1, float& m, float& l, f32x16 (&o)[NDB], LAS const unsigned char* vp) {
    float mx = fmaxf(s0[0], s1[0]);
#pragma unroll
    for (int i = 1; i < 16; ++i) mx = fmaxf(mx, fmaxf(s0[i], s1[i]));
    mx = fmaxf(mx, __shfl_xor(mx, 32));
    const float mn = fmaxf(m, mx), alpha = ex2(m - mn); m = mn;
    float ps = 0.f;
#pragma unroll
    for (int i = 0; i < 16; ++i) { s0[i] = ex2(s0[i] - mn); s1[i] = ex2(s1[i] - mn); ps += s0[i] + s1[i]; }
    l = l * alpha + ps;
#pragma unroll
    for (int db = 0; db < NDB; ++db) o[db] = o[db] * alpha;
    bf16x8 pf[4]; pf[0] = pack8(s0, 0); pf[1] = pack8(s0, 8); pf[2] = pack8(s1, 0); pf[3] = pack8(s1, 8);
    pv_tile<NDB>(o, vp, pf);
}
struct Lane { int tid, wid, lane, rho, hi, koff, voff; };
__device__ __forceinline__ Lane make_lane() {
    Lane L; L.tid = fresh_tid(); L.wid = __builtin_amdgcn_readfirstlane(L.tid >> 6); L.lane = L.tid & 63; L.rho = L.lane & 31; L.hi = L.lane >> 5;
    const int pr = (L.rho & ~12) | ((L.rho & 4) << 1) | ((L.rho & 8) >> 1);
    L.koff = pr * KROW + L.hi * 16; L.voff = L.rho * KROW + L.hi * 16; return L;
}
__device__ __forceinline__ void load_q(bf16x8 (&q)[4], const bf16_t* Qrow  ) {
#pragma unroll
    for (int d0 = 0; d0 < 4; ++d0) q[d0] = *(const bf16x8*)(Qrow + d0 * 16);
}

__device__ __forceinline__ void attnA_item(LAS unsigned char* lds, const Lane& L, const bf16_t* QK, const bf16_t* VTa, float* OA, int b, int h, int n, int qblk) {
    const int rowq = qblk * 256 + L.wid * 32, cw = rowq >> 6;
    const size_t tok0 = (size_t)b * SEQ;
    bf16x8 q[4]; load_q(q, QK + (tok0 + rowq + L.rho) * QKP + h * 128 + n * 64 + L.hi * 8);
    const bf16_t* Kb = QK + tok0 * QKP + 512 + h * 128 + n * 64;
    const bf16_t* Vb = VTa + (size_t)((b * 4 + h) * 128) * SEQ;
    const int NT = 4 * qblk + 4;
    TileRegs<128> tr;
    tile_load<128>(tr, Kb, Vb, 0, L.tid); tile_store<128>(tr, lds, L_K0, L_V0, L.tid); __syncthreads();
    float m = -1e30f, l = 0.f; f32x16 o[4];
#pragma unroll
    for (int db = 0; db < 4; ++db)
#pragma unroll
        for (int i = 0; i < 16; ++i) o[db][i] = 0.f;
    for (int t = 0; t < NT; ++t) {
        const int cur = t & 1;
        if (t + 1 < NT) tile_load<128>(tr, Kb, Vb, (t + 1) * 64, L.tid);
        if (t <= cw) {
            f32x16 s0, s1; qk_tile(s0, s1, lds + (cur ? L_K1 : L_K0) + L.koff, q);
            softmax_update<4>(s0, s1, m, l, o, lds + (cur ? L_V1 : L_V0) + L.voff);
        }
        if (t + 1 < NT) tile_store<128>(tr, lds, cur ? L_K0 : L_K1, cur ? L_V0 : L_V1, L.tid);
        __syncthreads();
    }
    l += __shfl_xor(l, 32);
    const float inv = 1.0f / l;
    float* op = OA + ((size_t)n * NTOK + tok0 + rowq + L.rho) * 512 + h * 128 + 4 * L.hi;
#pragma unroll
    for (int db = 0; db < 4; ++db)
#pragma unroll
        for (int g = 0; g < 4; ++g) { f32x4 v = {o[db][4 * g], o[db][4 * g + 1], o[db][4 * g + 2], o[db][4 * g + 3]}; *(f32x4*)(op + db * 32 + 8 * g) = v * inv; }
}
__device__ __forceinline__ void store_head_norm(const f32x16 (&o)[2], const Lane& L, const float* gain  , bf16_t* dst  ) {
    float ss = 0.f;
#pragma unroll
    for (int db = 0; db < 2; ++db)
#pragma unroll
        for (int i = 0; i < 16; ++i) ss += o[db][i] * o[db][i];
    ss += __shfl_xor(ss, 32);
    const float rs = rsqrtf(ss * (1.0f / 64.0f) + RMS_EPS);
#pragma unroll
    for (int db = 0; db < 2; ++db)
#pragma unroll
        for (int g = 0; g < 4; ++g) { const int d = db * 32 + 8 * g + 4 * L.hi; const f32x4 gv = *(const f32x4*)(gain + d);
            u32x2 w; w.x = cvtpk(o[db][4 * g] * rs * gv[0], o[db][4 * g + 1] * rs * gv[1]); w.y = cvtpk(o[db][4 * g + 2] * rs * gv[2], o[db][4 * g + 3] * rs * gv[3]);
            *(u32x2*)(dst + d) = w; }
}
__device__ __forceinline__ void attnB_item(LAS unsigned char* lds, const Lane& L, const bf16_t* QK, const bf16_t* VTb, bf16_t* CAT, const float* relb  , const float* gnb, int b, int h, int qblk) {
    const int rowq = qblk * 256 + L.wid * 32, cw = rowq >> 6;
    const size_t tok0 = (size_t)b * SEQ;
    LAS float* rb = (LAS float*)(lds + L_RB);
    if (L.tid < 257) rb[L.tid] = relb[h * 257 + L.tid] * LOG2E;
    bf16x8 q[4]; load_q(q, QK + (tok0 + rowq + L.rho) * QKP + 1024 + h * 64 + L.hi * 8);
    const bf16_t* Kb = QK + tok0 * QKP + 1280 + h * 64;
    const bf16_t* Vb = VTb + (size_t)((b * 4 + h) * 64) * SEQ;
    const int t_lo = (4 * qblk - 8) > 0 ? (4 * qblk - 8) : 0, t_hi = 4 * qblk + 3;
    TileRegs<64> tr;
    tile_load<64>(tr, Kb, Vb, t_lo * 64, L.tid); tile_store<64>(tr, lds, L_K0, L_V0, L.tid); __syncthreads();
    float m = -1e30f, l = 0.f; f32x16 o[2];
#pragma unroll
    for (int db = 0; db < 2; ++db)
#pragma unroll
        for (int i = 0; i < 16; ++i) o[db][i] = 0.f;
    const int qpos = rowq + L.rho;
    for (int t = t_lo; t <= t_hi; ++t) {
        const int cur = (t - t_lo) & 1;
        if (t < t_hi) tile_load<64>(tr, Kb, Vb, (t + 1) * 64, L.tid);
        if (t <= cw && t >= cw - 8) {
            f32x16 s0, s1; qk_tile(s0, s1, lds + (cur ? L_K1 : L_K0) + L.koff, q);
            if (cw - t >= 3) {
                const float bc = rb[256];
#pragma unroll
                for (int i = 0; i < 16; ++i) { s0[i] += bc; s1[i] += bc; }
            } else {
                const int rel0 = qpos - (t * 64 + 8 * L.hi);
#pragma unroll
                for (int r = 0; r < 16; ++r) { const int ko = 16 * (r >> 3) + (r & 7);
                    int i0 = rel0 - ko; i0 = (i0 > 128 ? 128 : i0) + 128; int i1 = rel0 - 32 - ko; i1 = (i1 > 128 ? 128 : i1) + 128;
                    s0[r] += rb[i0]; s1[r] += rb[i1]; }
            }
            softmax_update<2>(s0, s1, m, l, o, lds + (cur ? L_V1 : L_V0) + L.voff);
        }
        if (t < t_hi) tile_store<64>(tr, lds, cur ? L_K0 : L_K1, cur ? L_V0 : L_V1, L.tid);
        __syncthreads();
    }
    l += __shfl_xor(l, 32);
    const float inv = 1.0f / l;
#pragma unroll
    for (int db = 0; db < 2; ++db) o[db] = o[db] * inv;
    store_head_norm(o, L, gnb + h * 64, CAT + (tok0 + rowq + L.rho) * 1024 + 512 + h * 64);
}
__device__ __forceinline__ void stick_block(const f32x16& y, int kbase, int lim, int hi, float& R, bf16x8& pf0, bf16x8& pf1) {
    f32x16 ls, lb;
#pragma unroll
    for (int r = 0; r < 16; ++r) {
        const int kpos = kbase + 16 * (r >> 3) + 8 * hi + (r & 7);
        const float yy = y[r], sp = fmaxf(yy, 0.f) + lg2(1.0f + ex2(-fabsf(yy)));
        const bool valid = kpos < lim;
        ls[r] = valid ? -sp : 0.f;
        lb[r] = valid ? (yy - sp) : -1e30f;
    }
    float g0 = 0.f, g1 = 0.f;
#pragma unroll
    for (int i = 0; i < 8; ++i) { g0 += ls[i]; g1 += ls[8 + i]; }
    const float p0 = __shfl_xor(g0, 32), p1 = __shfl_xor(g1, 32);
    const float G11 = hi ? g1 : p1, G01 = hi ? p1 : g1, G10 = hi ? g0 : p0, G00 = hi ? p0 : g0;
    float run1 = R + (hi ? 0.f : G11);
    float run0 = R + (G11 + G01) + (hi ? 0.f : G10);
    f32x16 a;
#pragma unroll
    for (int i = 7; i >= 0; --i) {
        a[8 + i] = ex2(lb[8 + i] + run1); run1 += ls[8 + i];
        a[i] = ex2(lb[i] + run0); run0 += ls[i];
    }
    R += (G11 + G01) + (G10 + G00);
    pf0 = pack8(a, 0); pf1 = pack8(a, 8);
}
__device__ __forceinline__ void attnC_item(LAS unsigned char* lds, const Lane& L, const bf16_t* QK, const bf16_t* VTc, bf16_t* CAT, const float* gnc, int b, int h, int qblk) {
    const int rowq = qblk * 256 + L.wid * 32, cw = rowq >> 6;
    const size_t tok0 = (size_t)b * SEQ;
    volatile LAS unsigned* flag = (volatile LAS unsigned*)(lds + L_FLAG);
    bf16x8 q[4]; load_q(q, QK + (tok0 + rowq + L.rho) * QKP + 1536 + h * 64 + L.hi * 8);
    const bf16_t* Kb = QK + tok0 * QKP + 1792 + h * 64;
    const bf16_t* Vb = VTc + (size_t)((b * 4 + h) * 64) * SEQ;
    const int t_hi = 4 * qblk + 3;
    TileRegs<64> tr;
    tile_load<64>(tr, Kb, Vb, t_hi * 64, L.tid); tile_store<64>(tr, lds, L_K0, L_V0, L.tid); __syncthreads();
    float R = 0.f; f32x16 o[2];
#pragma unroll
    for (int db = 0; db < 2; ++db)
#pragma unroll
        for (int i = 0; i < 16; ++i) o[db][i] = 0.f;
    const int qpos = rowq + L.rho;
    bool wdone = false;
    for (int t = t_hi; t >= 0; --t) {
        const int it = t_hi - t, cur = it & 1;
        if (t > 0) tile_load<64>(tr, Kb, Vb, (t - 1) * 64, L.tid);
        if (t <= cw && !wdone) {
            f32x16 s0, s1; qk_tile(s0, s1, lds + (cur ? L_K1 : L_K0) + L.koff, q);
            const int lim = (t == cw) ? qpos : 0x7fffffff;
            bf16x8 pf[4];
            stick_block(s1, t * 64 + 32, lim, L.hi, R, pf[2], pf[3]);
            stick_block(s0, t * 64, lim, L.hi, R, pf[0], pf[1]);
            pv_tile<2>(o, lds + (cur ? L_V1 : L_V0) + L.voff, pf);
            wdone = __all(R < -150.0f) != 0;
        }
        if (L.lane == 0) flag[cur * 8 + L.wid] = (wdone || t == 0) ? 1u : 0u;
        if (t > 0) tile_store<64>(tr, lds, cur ? L_K0 : L_K1, cur ? L_V0 : L_V1, L.tid);
        __syncthreads();
        unsigned alld = 1u;
#pragma unroll
        for (int w = 0; w < 8; ++w) alld &= flag[cur * 8 + w];
        if (alld) break;
    }
    __syncthreads();
    store_head_norm(o, L, gnc + h * 64, CAT + (tok0 + rowq + L.rho) * 1024 + 768 + h * 64);
}
}

__device__ __forceinline__ void store_row_bf16(bf16_t* orow, const f32x4 (&v)[4], int lane) {
#pragma unroll
    for (int j = 0; j < 4; ++j) { u32x2 w; w.x = cvtpk(v[j][0], v[j][1]); w.y = cvtpk(v[j][2], v[j][3]); *((u32x2*)orow + lane + 64 * j) = w; }
}
__device__ __forceinline__ void prenorm_pass(const float* x, const float* g, bf16_t* HN, int gw, int NGW, int lane) {
    for (int m = gw; m < NTOK; m += NGW) {
        const f32x4* xr = (const f32x4*)(x + (size_t)m * DM) + lane; f32x4 v[4]; float s = 0.f;
#pragma unroll
        for (int j = 0; j < 4; ++j) { v[j] = xr[64 * j]; s += (v[j][0] * v[j][0] + v[j][1] * v[j][1]) + (v[j][2] * v[j][2] + v[j][3] * v[j][3]); }
        const float rs = rsqrtf(wave_sum(s) * (1.0f / DM) + RMS_EPS);
#pragma unroll
        for (int j = 0; j < 4; ++j) v[j] = v[j] * rs * ((const f32x4*)g)[lane + 64 * j];
        store_row_bf16(HN + (size_t)m * DM, v, lane);
    }
}
__device__ __forceinline__ void postnorm_pass(const float* Y, const float* xin, float* xout, const float* gpost, const float* gnext, bf16_t* HN, int gw, int NGW, int lane) {
    for (int m = gw; m < NTOK; m += NGW) {
        const f32x4* yr = (const f32x4*)(Y + (size_t)m * DM) + lane; const f32x4* xr = (const f32x4*)(xin + (size_t)m * DM) + lane;
        f32x4 y[4], v[4]; float s = 0.f;
#pragma unroll
        for (int j = 0; j < 4; ++j) { y[j] = yr[64 * j]; v[j] = xr[64 * j]; s += (y[j][0] * y[j][0] + y[j][1] * y[j][1]) + (y[j][2] * y[j][2] + y[j][3] * y[j][3]); }
        const float rs = rsqrtf(wave_sum(s) * (1.0f / DM) + RMS_EPS);
        float s2 = 0.f;
#pragma unroll
        for (int j = 0; j < 4; ++j) { v[j] = v[j] + y[j] * rs * ((const f32x4*)gpost)[lane + 64 * j]; s2 += (v[j][0] * v[j][0] + v[j][1] * v[j][1]) + (v[j][2] * v[j][2] + v[j][3] * v[j][3]); }
        f32x4* xo = (f32x4*)(xout + (size_t)m * DM) + lane;
#pragma unroll
        for (int j = 0; j < 4; ++j) xo[64 * j] = v[j];
        if (gnext) {
            const float rs2 = rsqrtf(wave_sum(s2) * (1.0f / DM) + RMS_EPS);
#pragma unroll
            for (int j = 0; j < 4; ++j) v[j] = v[j] * rs2 * ((const f32x4*)gnext)[lane + 64 * j];
            store_row_bf16(HN + (size_t)m * DM, v, lane);
        }
    }
}
__device__ __forceinline__ void combine_pass(const float* OA, bf16_t* CAT, const float* subln, float lam, float oscale, int gw, int NGW, int lane) {
    const int e0 = (lane & 15) * 8;
    const f32x4 g0 = *(const f32x4*)(subln + e0), g1 = *(const f32x4*)(subln + e0 + 4);
    for (int m = gw; m < NTOK; m += NGW) {
        const f32x4* a = (const f32x4*)(OA + (size_t)m * 512) + 2 * lane; const f32x4* c = (const f32x4*)(OA + ((size_t)NTOK + m) * 512) + 2 * lane;
        f32x4 d0 = a[0] - c[0] * lam, d1 = a[1] - c[1] * lam;
        float ss = (d0[0] * d0[0] + d0[1] * d0[1]) + (d0[2] * d0[2] + d0[3] * d0[3]) + (d1[0] * d1[0] + d1[1] * d1[1]) + (d1[2] * d1[2] + d1[3] * d1[3]);
#pragma unroll
        for (int o = 1; o < 16; o <<= 1) ss += __shfl_xor(ss, o);
        const float rs = rsqrtf(ss * (1.0f / 128.0f) + RMS_EPS) * oscale;
        d0 = d0 * rs * g0; d1 = d1 * rs * g1;
        u32x4 w; w.x = cvtpk(d0[0], d0[1]); w.y = cvtpk(d0[2], d0[3]); w.z = cvtpk(d1[0], d1[1]); w.w = cvtpk(d1[2], d1[3]);
        *((u32x4*)(CAT + (size_t)m * 1024) + lane) = w;
    }
}
__device__ __forceinline__ void transpose_item(const float* W, int K, int N, bf16_t* WT, LAS float* scr, int item, int lane) {
    const int nblk = N / 32, kb = item / nblk, nb = item % nblk, k0 = 64 * kb, n0 = 32 * nb;
#pragma unroll 8
    for (int i = 0; i < 32; ++i) { const int kk = 2 * i + (lane >> 5); scr[kk * 33 + (lane & 31)] = W[(size_t)(k0 + kk) * N + n0 + (lane & 31)]; }
    asm volatile("s_waitcnt lgkmcnt(0)" ::: "memory");
    const int c = lane & 7;
#pragma unroll
    for (int j = 0; j < 4; ++j) { const int n = (lane >> 3) + 8 * j; const LAS float* s = scr + (8 * c) * 33 + n;
        u32x4 o; o.x = cvtpk(s[0 * 33], s[1 * 33]); o.y = cvtpk(s[2 * 33], s[3 * 33]); o.z = cvtpk(s[4 * 33], s[5 * 33]); o.w = cvtpk(s[6 * 33], s[7 * 33]);
        *(u32x4*)(WT + (size_t)(n0 + n) * K + k0 + 8 * c) = o; }
    asm volatile("s_waitcnt lgkmcnt(0)" ::: "memory");
}

struct Args {
    const float* x; const float* g_pre_mix; const float* w_in; const float* lq1; const float* lk1; const float* lq2; const float* lk2;
    const float* subln; const float* relb; const float* gnb; const float* gnc; const float* w_out; const float* g_post_mix; const float* g_pre_mlp;
    const float* w_up; const float* w_down; const float* g_post_mlp;
    float* out; unsigned char* ws;
    float inv_freq[8]; float lam_init[2]; int ph_lo, ph_hi, coop, pad;
};
constexpr int NPHASE = 1 + 8 * NLAYER;
constexpr int LDS_BYTES = 147456;

__device__ __forceinline__ void convert_weights(const Args& a, int l, LAS unsigned char* lds, int gw, int NGW, int wave, int lane) {
    LAS float* scr = (LAS float*)(lds + wave * 16384);
    constexpr int I_IN = (DM / 64) * (DIN / 32), I_O = (DM / 64) * (DM / 32), I_U = (DM / 64) * (DFF / 32), I_D = (DFF / 64) * (DM / 32);
    constexpr int NITEMS = I_IN + I_O + I_U + I_D;
    bf16_t* Wi = (bf16_t*)(a.ws + WS_WI); bf16_t* Wo = (bf16_t*)(a.ws + WS_WO); bf16_t* Wu = (bf16_t*)(a.ws + WS_WU); bf16_t* Wd = (bf16_t*)(a.ws + WS_WD);
    for (int it = gw; it < NITEMS; it += NGW) {
        int r = it;
        if (r < I_IN) { transpose_item(a.w_in + (size_t)l * DM * DIN, DM, DIN, Wi, scr, r, lane); continue; } r -= I_IN;
        if (r < I_O) { transpose_item(a.w_out + (size_t)l * DM * DM, DM, DM, Wo, scr, r, lane); continue; } r -= I_O;
        if (r < I_U) { transpose_item(a.w_up + (size_t)l * DM * DFF, DM, DFF, Wu, scr, r, lane); continue; } r -= I_U;
        transpose_item(a.w_down + (size_t)l * DFF * DM, DFF, DM, Wd, scr, r, lane);
    }
}

__global__ void __launch_bounds__(512, 2) mk_fwd(Args a) {
    extern __shared__ __attribute__((aligned(16))) unsigned char lds_raw[];
    LAS unsigned char* lds = (LAS unsigned char*)lds_raw;
    cg::grid_group grid = cg::this_grid();
    const int G = gridDim.x, bx = blockIdx.x;
    const int vcu = (G % 8 == 0) ? (bx % 8) * (G / 8) + bx / 8 : bx;
    const int NGW = G * 8;
#define FRESH_IDS() const int tid = fresh_tid(), lane = tid & 63, wave = __builtin_amdgcn_readfirstlane(tid >> 6), gw = vcu * 8 + wave; (void)tid; (void)lane; (void)gw
    unsigned char* ws = a.ws;
    bf16_t* Wi = (bf16_t*)(ws + WS_WI); bf16_t* Wo = (bf16_t*)(ws + WS_WO); bf16_t* Wu = (bf16_t*)(ws + WS_WU); bf16_t* Wd = (bf16_t*)(ws + WS_WD);
    bf16_t* HN = (bf16_t*)(ws + WS_HN); float* Y = (float*)(ws + WS_Y); bf16_t* QK = (bf16_t*)(ws + WS_QK); bf16_t* U = (bf16_t*)(ws + WS_U);
    bf16_t* VTa = (bf16_t*)(ws + WS_VTA); bf16_t* VTb = (bf16_t*)(ws + WS_VTB); bf16_t* VTc = (bf16_t*)(ws + WS_VTC);
    float* OA = (float*)(ws + WS_OA); bf16_t* CAT = (bf16_t*)(ws + WS_CAT); float* rope = (float*)(ws + WS_ROPE);

    const int lo = a.ph_lo, hi = a.ph_hi;
    volatile LAS unsigned* bst = (volatile LAS unsigned*)(lds + LDS_BYTES - 64);
    if (threadIdx.x < 16) bst[threadIdx.x] = 0u;
    __syncthreads();
    XcdBarrier bar; bar.bar = (unsigned*)ws; bar.x = 0; bar.st = bst;
    if (a.coop) bar = xcd_barrier_post((unsigned*)ws, bst);
    if (a.pad == 0x7fffffff) grid.sync();
#define IN(p) (lo <= (p) && (p) < hi)
#define SEAM(p) do { if (IN((p) + 1) && a.coop) xcd_barrier(bar); } while (0)
    if (IN(0)) {
        FRESH_IDS();
        convert_weights(a, 0, lds, gw, NGW, wave, lane);
        for (int p = bx * 512 + tid; p < SEQ; p += G * 512) {
            f32x4 c[2], s[2];
#pragma unroll
            for (int j = 0; j < 8; ++j) {
                const float ang = (float)p * a.inv_freq[j];
                double t = (double)ang * 0.15915494309189535; t -= rint(t);
                const float tf = (float)t;
                c[j >> 2][j & 3] = __builtin_amdgcn_cosf(tf); s[j >> 2][j & 3] = __builtin_amdgcn_sinf(tf);
            }
            f32x4* o = (f32x4*)(rope + (size_t)p * 16); o[0] = c[0]; o[1] = c[1]; o[2] = s[0]; o[3] = s[1];
        }
        prenorm_pass(a.x, a.g_pre_mix, HN, gw, NGW, lane);
        SEAM(0);
    }
    for (int l = 0; l < NLAYER; ++l) {
        const int p0 = 1 + 8 * l;
        if (IN(p0)) {
            pg8::Gemm g{HN, Wi, NTOK, DIN, DM}; pg8::StaticOrder S; S.init(NTOK, DIN, G, bx);
            pg8::EpiProj E{QK, VTa, rope};
            pg8::gemm_phase<pg8::EpiProj, pg8::StaticOrder, true, true>(lds, g, S, E);
            SEAM(p0);
        }
        if (IN(p0 + 1)) {
            const att::Lane L = att::make_lane();
            for (int rep = 0; rep < PROBE_REP_A; ++rep)
            for (int it = vcu; it < 256; it += G) {
                const int combo = it >> 3, s = it & 7, b = combo >> 3, h = (combo >> 1) & 3, n = combo & 1;
                att::attnA_item(lds, L, QK, VTa, OA, b, h, n, 15 - s);
                att::attnA_item(lds, L, QK, VTa, OA, b, h, n, s);
            }
            for (int rep = 0; rep < PROBE_REP_B; ++rep)
            for (int it = vcu; it < 256; it += G) {
                const int b = it >> 6, h = (it >> 4) & 3, qblk = it & 15;
                att::attnB_item(lds, L, QK, VTb, CAT, a.relb + (size_t)l * 4 * 257, a.gnb + l * 256, b, h, qblk);
            }
            for (int rep = 0; rep < PROBE_REP_C; ++rep)
            for (int it = vcu; it < 256; it += G) {
                const int b = it >> 6, h = (it >> 4) & 3, qblk = it & 15;
                att::attnC_item(lds, L, QK, VTc, CAT, a.gnc + l * 256, b, h, qblk);
            }
            SEAM(p0 + 1);
        }
        if (IN(p0 + 2)) {
            FRESH_IDS();
            const float li = (l == 0) ? a.lam_init[0] : a.lam_init[1];
            const float s1 = wave_sum(a.lq1[l * 64 + lane] * a.lk1[l * 64 + lane]), s2 = wave_sum(a.lq2[l * 64 + lane] * a.lk2[l * 64 + lane]);
            const float lam = expf(s1) - expf(s2) + li;
            combine_pass(OA, CAT, a.subln + l * 128, lam, 1.0f - li, gw, NGW, lane);
            SEAM(p0 + 2);
        }
        if (IN(p0 + 3)) {
            pg8::Gemm g{CAT, Wo, NTOK, DM, DM}; pg8::StaticOrder S; S.init(NTOK, DM, G, bx);
            pg8::EpiF32 E{Y, DM};
            pg8::gemm_phase<pg8::EpiF32, pg8::StaticOrder, true, true>(lds, g, S, E);
            SEAM(p0 + 3);
        }
        if (IN(p0 + 4)) {
            FRESH_IDS();
            postnorm_pass(Y, l == 0 ? a.x : a.out, a.out, a.g_post_mix + l * DM, a.g_pre_mlp + l * DM, HN, gw, NGW, lane);
            SEAM(p0 + 4);
        }
        if (IN(p0 + 5)) {
            pg8::Gemm g{HN, Wu, NTOK, DFF, DM}; pg8::StaticOrder S; S.init(NTOK, DFF, G, bx);
            pg8::EpiRelu2 E{U, DFF};
            pg8::gemm_phase<pg8::EpiRelu2, pg8::StaticOrder, true, true>(lds, g, S, E);
            SEAM(p0 + 5);
        }
        if (IN(p0 + 6)) {
            pg8::Gemm g{U, Wd, NTOK, DM, DFF}; pg8::StaticOrder S; S.init(NTOK, DM, G, bx);
            pg8::EpiF32 E{Y, DM};
            pg8::gemm_phase<pg8::EpiF32, pg8::StaticOrder, true, true>(lds, g, S, E);
            SEAM(p0 + 6);
        }
        if (IN(p0 + 7)) {
            FRESH_IDS();
            postnorm_pass(Y, a.out, a.out, a.g_post_mlp + l * DM, (l + 1 < NLAYER) ? a.g_pre_mix + (l + 1) * DM : nullptr, HN, gw, NGW, lane);
            if (l + 1 < NLAYER) convert_weights(a, l + 1, lds, gw, NGW, wave, lane);
            SEAM(p0 + 7);
        }
    }
#undef IN
#undef SEAM
}

extern "C" void kernel_launch(void* const* d_in, const int* in_sizes, int n_in, void* d_out, int out_size, void* d_ws, size_t ws_size, hipStream_t stream) {
    static int grid_blocks = 0;
    if (grid_blocks == 0) {
        if (n_in != 17 || ws_size < WS_END) { fprintf(stderr, "kernel_launch: unexpected inputs (n_in %d, ws %zu)\n", n_in, ws_size); grid_blocks = -1; return; }
        int dev = 0, cus = 0, per_cu = 0;
        hipGetDevice(&dev);
        hipDeviceGetAttribute(&cus, hipDeviceAttributeMultiprocessorCount, dev);
        if (hipFuncSetAttribute((const void*)mk_fwd, hipFuncAttributeMaxDynamicSharedMemorySize, LDS_BYTES) != hipSuccess) fprintf(stderr, "kernel_launch: hipFuncSetAttribute failed\n");
        if (hipOccupancyMaxActiveBlocksPerMultiprocessor(&per_cu, (const void*)mk_fwd, 512, LDS_BYTES) != hipSuccess || per_cu < 1) { fprintf(stderr, "kernel_launch: occupancy query gave %d\n", per_cu); per_cu = 1; }
        (void)hipGetLastError();
        grid_blocks = cus * per_cu;
        if (grid_blocks % 8 != 0 || grid_blocks > 1024) grid_blocks = cus;
    }
    if (grid_blocks < 0) return;
    if (hipMemsetAsync(d_ws, 0, 16384, stream) != hipSuccess) fprintf(stderr, "kernel_launch: hipMemsetAsync failed\n");
    Args a{};
    a.x = (const float*)d_in[0]; a.g_pre_mix = (const float*)d_in[1]; a.w_in = (const float*)d_in[2]; a.lq1 = (const float*)d_in[3]; a.lk1 = (const float*)d_in[4];
    a.lq2 = (const float*)d_in[5]; a.lk2 = (const float*)d_in[6]; a.subln = (const float*)d_in[7]; a.relb = (const float*)d_in[8]; a.gnb = (const float*)d_in[9];
    a.gnc = (const float*)d_in[10]; a.w_out = (const float*)d_in[11]; a.g_post_mix = (const float*)d_in[12]; a.g_pre_mlp = (const float*)d_in[13];
    a.w_up = (const float*)d_in[14]; a.w_down = (const float*)d_in[15]; a.g_post_mlp = (const float*)d_in[16];
    a.out = (float*)d_out; a.ws = (unsigned char*)d_ws;
    for (int j = 0; j < 8; ++j) a.inv_freq[j] = powf(500000.0f, -(float)(2 * j) / 16.0f);
    for (int l = 0; l < 2; ++l) a.lam_init[l] = (float)(0.8 - 0.6 * exp(-0.3 * (double)l));
    a.pad = 0;
#if MK_SPLIT
    a.coop = 0;
    for (int ph = 0; ph < NPHASE; ++ph) { a.ph_lo = ph; a.ph_hi = ph + 1; hipLaunchKernelGGL(mk_fwd, dim3(grid_blocks), dim3(512), LDS_BYTES, stream, a); }
#else
    a.coop = 1; a.ph_lo = 0; a.ph_hi = NPHASE;
    void* args[] = {&a};
    hipError_t e = hipLaunchCooperativeKernel((const void*)mk_fwd, dim3(grid_blocks), dim3(512), args, LDS_BYTES, stream);
    if (e != hipSuccess) fprintf(stderr, "cooperative launch failed: %s (grid %d)\n", hipGetErrorString(e), grid_blocks);
#endif
}
```

```cpp
#include <hip/hip_runtime.h>
#include <hip/hip_cooperative_groups.h>
#include <cstdio>
#include <cstdint>
#include <cmath>
namespace cg = cooperative_groups;
#ifndef MK_SPLIT
#define MK_SPLIT 0
#endif

#ifndef PROBE_REP_A
#define PROBE_REP_A 1
#endif
#ifndef PROBE_REP_B
#define PROBE_REP_B 1
#endif
#ifndef PROBE_REP_C
#define PROBE_REP_C 1
#endif
#ifndef PROBE_REP_G
#define PROBE_REP_G 1
#endif
constexpr int SEQ = 4096, NBATCH = 4, DM = 1024, DFF = 4096, DIN = 3072, NTOK = NBATCH * SEQ, NLAYER = 2;
constexpr int QKP = 2048;
constexpr size_t VTB_OFF = (size_t)8 << 20, VTC_OFF = (size_t)12 << 20;
constexpr float RMS_EPS = 1e-6f;
constexpr float LOG2E = 1.4426950408889634f;
constexpr float QSCALE = 0.125f * LOG2E;

#define LAS __attribute__((address_space(3)))
__device__ __forceinline__ int fresh_tid() { int t = threadIdx.x; asm volatile("" : "+v"(t)); return t; }

namespace pg8 {
#define PG8_LAS __attribute__((address_space(3)))
typedef unsigned short bf16_t;
typedef short bf16x8 __attribute__((ext_vector_type(8)));
typedef float f32x4 __attribute__((ext_vector_type(4)));
typedef unsigned u32x4 __attribute__((ext_vector_type(4)));
constexpr int BM = 256, BK = 64, HALF = 128, HTB = HALF * BK * 2  , STAGE_BYTES = 8 * HTB, NXCD = 8, WGM = 8;

__host__ __device__ __forceinline__ int lds_byte(int r, int c) { const int st = (r >> 4) * 2 + (c >> 5), rr = r & 15, cc = c & 31, ob = rr * 64 + cc * 2; return st * 1024 + (ob ^ (((ob >> 9) & 1) << 5)); }
__host__ __device__ __forceinline__ void stage_rc(int b, int& R, int& C) { const int st = b / 1024, sb = b % 1024, swz = sb ^ (((sb >> 9) & 1) << 5); R = (st >> 1) * 16 + swz / 64; C = (st & 1) * 32 + (swz % 64) / 2; }
__host__ __device__ __forceinline__ int perm32(int rho) { const int n = rho >> 4, i = rho & 15; return 8 * (i >> 2) + 4 * n + (i & 3); }

struct Unit { int pm, pn; };
struct Gemm { const bf16_t* A; const bf16_t* Bt; int M, N, K; };

struct StaticOrder {
    int nM, nN, nwg, G, c;
    __host__ __device__ void init(int M, int N, int G_, int c_) { nM = M / BM; nN = N / BM; nwg = nM * nN; G = G_; c = c_; }
    __host__ __device__ bool next(int i, Unit& u) const {
        const long L = (long)i * G + c; if (L >= nwg) return false;
        int wgid = (int)L; { const int q = nwg / NXCD, r = nwg % NXCD, xcd = wgid % NXCD, off = wgid / NXCD; wgid = (xcd < r ? xcd * (q + 1) : r * (q + 1) + (xcd - r) * q) + off; }
        const int nig = WGM * nN, gid = wgid / nig, fm = gid * WGM, gsz = (nM - fm) < WGM ? (nM - fm) : WGM;
        u.pm = fm + ((wgid % nig) % gsz); u.pn = (wgid % nig) / gsz; return true;
    }
    __device__ __forceinline__ void a_ready(const Unit&) const {}
    __device__ __forceinline__ void done(const Unit&) const {}
};

__device__ __forceinline__ unsigned cvt_pk_bf16(float lo, float hi) { unsigned r; asm volatile("v_cvt_pk_bf16_f32 %0, %1, %2" : "=v"(r) : "v"(lo), "v"(hi)); return r; }
typedef float f32x2 __attribute__((ext_vector_type(2)));
typedef float f32x2 __attribute__((ext_vector_type(2)));
typedef __bf16 bf16x2_t __attribute__((ext_vector_type(2)));
__device__ __forceinline__ unsigned cvtpk(float lo, float hi) { f32x2 v = {lo, hi}; bf16x2_t b = __builtin_convertvector(v, bf16x2_t); return __builtin_bit_cast(unsigned, b); }
__device__ __forceinline__ bf16_t cvt1(float v) { return (bf16_t)(cvtpk(v, 0.f) & 0xffffu); }

struct EpiProj {
    static constexpr bool PERM = true, AFTER_DRAIN = false;
    bf16_t* QK; bf16_t* VT; const float* rope;
    __device__ __forceinline__ void operator()(const f32x4 (&acc)[2][2][4][2], const Unit& u, int wr, int wc, int fr, int fq) const {
        const int pn = u.pn;
        const int row0 = u.pm * BM + wr * 64 + fr;
        const int cin = wc * 32 + 8 * fq;
        if (pn == 4 || pn == 5 || pn == 8 || pn == 11) {
            const size_t voff = (pn <= 5) ? (size_t)0 : (pn == 8 ? VTB_OFF : VTC_OFF);
            bf16_t* base = VT + voff;
            const int nd = (pn <= 5) ? 128 : 64, c0 = (pn == 5) ? 256 : 0;
#pragma unroll
            for (int ai = 0; ai < 2; ++ai)
#pragma unroll
                for (int m = 0; m < 4; ++m) {
                    const int row = row0 + ai * HALF + m * 16, b = row >> 12, s = row & (SEQ - 1);
#pragma unroll
                    for (int bj = 0; bj < 2; ++bj) {
                        const int c = c0 + bj * HALF + cin;
                        const int h = c / nd, e = c % nd;
                        bf16_t* p = base + ((size_t)((b * 4 + h) * nd + e)) * SEQ + s;
#pragma unroll
                        for (int n = 0; n < 2; ++n)
#pragma unroll
                            for (int i = 0; i < 4; ++i) p[(size_t)(4 * n + i) * SEQ] = cvt1(acc[ai][bj][m][n][i]);
                    }
                }
            return;
        }
        int dcol; bool rope_on = false; float sc = 1.f;
        if (pn <= 1) { dcol = pn * 256; rope_on = true; sc = QSCALE; }
        else if (pn <= 3) { dcol = 512 + (pn - 2) * 256; rope_on = true; }
        else if (pn == 6) { dcol = 1024; sc = QSCALE; }
        else if (pn == 7) { dcol = 1280; }
        else if (pn == 9) { dcol = 1536; sc = QSCALE; }
        else { dcol = 1792; }
        const bool rl = ((wc & 1) == 0) && (fq < 2);
#pragma unroll
        for (int ai = 0; ai < 2; ++ai)
#pragma unroll
            for (int m = 0; m < 4; ++m) {
                const int row = row0 + ai * HALF + m * 16;
#pragma unroll
                for (int bj = 0; bj < 2; ++bj) {
                    f32x4 v0 = acc[ai][bj][m][0], v1 = acc[ai][bj][m][1];
                    if (rope_on) {
                        f32x4 o0, o1;
#pragma unroll
                        for (int i = 0; i < 4; ++i) { o0[i] = __shfl_xor(v0[i], 16); o1[i] = __shfl_xor(v1[i], 16); }
                        if (rl) {
                            const f32x4* t = (const f32x4*)(rope + (size_t)(row & (SEQ - 1)) * 16);
                            const f32x4 c0 = t[0], c1 = t[1], s0 = t[2], s1 = t[3];
                            if (fq == 0) { v0 = v0 * c0 - o0 * s0; v1 = v1 * c1 - o1 * s1; }
                            else         { v0 = v0 * c0 + o0 * s0; v1 = v1 * c1 + o1 * s1; }
                        }
                    }
                    v0 = v0 * sc; v1 = v1 * sc;
                    u32x4 w; w.x = cvtpk(v0[0], v0[1]); w.y = cvtpk(v0[2], v0[3]); w.z = cvtpk(v1[0], v1[1]); w.w = cvtpk(v1[2], v1[3]);
                    *(u32x4*)(QK + (size_t)row * QKP + dcol + bj * HALF + cin) = w;
                }
            }
    }
};
struct EpiY {
    static constexpr bool PERM = true, AFTER_DRAIN = false;
    bf16_t* O; int ldc;
    __device__ __forceinline__ void operator()(const f32x4 (&acc)[2][2][4][2], const Unit& u, int wr, int wc, int fr, int fq) const {
        const int row0 = u.pm * BM + wr * 64 + fr, col0 = u.pn * BM + wc * 32 + 8 * fq;
#pragma unroll
        for (int ai = 0; ai < 2; ++ai)
#pragma unroll
            for (int m = 0; m < 4; ++m) { bf16_t* rowp = O + (size_t)(row0 + ai * HALF + m * 16) * ldc + col0;
#pragma unroll
                for (int bj = 0; bj < 2; ++bj) { const f32x4 v0 = acc[ai][bj][m][0], v1 = acc[ai][bj][m][1];
                    u32x4 w; w.x = cvtpk(v0[0], v0[1]); w.y = cvtpk(v0[2], v0[3]); w.z = cvtpk(v1[0], v1[1]); w.w = cvtpk(v1[2], v1[3]);
                    *(u32x4*)(rowp + bj * HALF) = w; } }
    }
};
struct EpiRelu2 {
    static constexpr bool PERM = true, AFTER_DRAIN = false;
    bf16_t* O; int ldc;
    __device__ __forceinline__ void operator()(const f32x4 (&acc)[2][2][4][2], const Unit& u, int wr, int wc, int fr, int fq) const {
        const int row0 = u.pm * BM + wr * 64 + fr, col0 = u.pn * BM + wc * 32 + 8 * fq;
#pragma unroll
        for (int ai = 0; ai < 2; ++ai)
#pragma unroll
            for (int m = 0; m < 4; ++m) { bf16_t* rowp = O + (size_t)(row0 + ai * HALF + m * 16) * ldc + col0;
#pragma unroll
                for (int bj = 0; bj < 2; ++bj) { f32x4 v0 = acc[ai][bj][m][0], v1 = acc[ai][bj][m][1];
#pragma unroll
                    for (int i = 0; i < 4; ++i) { const float a = fmaxf(v0[i], 0.f), b = fmaxf(v1[i], 0.f); v0[i] = a * a; v1[i] = b * b; }
                    u32x4 w; w.x = cvtpk(v0[0], v0[1]); w.y = cvtpk(v0[2], v0[3]); w.z = cvtpk(v1[0], v1[1]); w.w = cvtpk(v1[2], v1[3]);
                    *(u32x4*)(rowp + bj * HALF) = w; } }
    }
};

template <class Epi, class Sched, bool ALIGN_EPI = false, bool SP2 = false>
__device__ __forceinline__ void gemm_phase(PG8_LAS unsigned char* lds, const Gemm g, const Sched& S, const Epi& E) {
    const int tid = fresh_tid(), wid = __builtin_amdgcn_readfirstlane(tid >> 6), lane = tid & 63, wr = wid >> 2, wc = wid & 3, fr = lane & 15, fq = lane >> 4;
    const int K = g.K, nt = K / BK;
    unsigned voffA[2], voffB[2];
#pragma unroll
    for (int i = 0; i < 2; ++i) { int R, C; stage_rc(tid * 16 + i * 8192, R, C); const int Rb = Epi::PERM ? ((R & ~31) + perm32(R & 31)) : R;
        voffA[i] = (unsigned)(R * K + C) * 2u; voffB[i] = (unsigned)(Rb * K + C) * 2u; }
    const size_t kstep = (size_t)(BK * 2);
    const size_t hstep = (size_t)HALF * K * 2;
    const size_t tstep = 2 * hstep;
    const unsigned ldsw = (unsigned)wid * 1024u;
    const int aoff = lds_byte(wr * 64 + fr, fq * 8), boff = lds_byte(wc * 32 + fr, fq * 8);
#define PG8_SA(b, h) (((b) * 2 + (h)) * HTB)
#define PG8_SB(b, h) ((4 + (b) * 2 + (h)) * HTB)
#define PG8_STAGE(bufoff, gbase, voff) do { _Pragma("unroll") for (int _i = 0; _i < 2; ++_i) \
        __builtin_amdgcn_global_load_lds((const unsigned*)((const char*)(gbase) + (voff)[_i]), (PG8_LAS unsigned*)(lds + (bufoff) + ldsw + _i * 8192), 16, 0, 0); } while (0)
#define PG8_LDA(dst, b, h) do { _Pragma("unroll") for (int m = 0; m < 4; ++m) _Pragma("unroll") for (int k = 0; k < 2; ++k) dst[m][k] = *(const PG8_LAS bf16x8*)(lds + PG8_SA(b, h) + aoff + m * 2048 + k * 1024); } while (0)
#define PG8_LDB(dst, b, h) do { _Pragma("unroll") for (int n = 0; n < 2; ++n) _Pragma("unroll") for (int k = 0; k < 2; ++k) dst[n][k] = *(const PG8_LAS bf16x8*)(lds + PG8_SB(b, h) + boff + n * 2048 + k * 1024); } while (0)
#define PG8_MMA(ai, bj, At, Bt) do { __builtin_amdgcn_s_setprio(1); _Pragma("unroll") for (int m = 0; m < 4; ++m) _Pragma("unroll") for (int n = 0; n < 2; ++n) _Pragma("unroll") for (int k = 0; k < 2; ++k) \
        acc[ai][bj][m][n] = __builtin_amdgcn_mfma_f32_16x16x32_bf16(Bt[n][k], At[m][k], acc[ai][bj][m][n], 0, 0, 0); __builtin_amdgcn_s_setprio(0); } while (0)
#define PG8_WAIT_V(n) asm volatile("s_waitcnt vmcnt(" #n ")" ::: "memory")
#define PG8_WAIT_L(n) asm volatile("s_waitcnt lgkmcnt(" #n ")" ::: "memory")
#define PG8_BAR __builtin_amdgcn_s_barrier()
#define PG8_SCHED __builtin_amdgcn_sched_barrier(0)
    Unit cur, nxt; int ui = 0;
    if (!S.next(0, cur)) return;
    f32x4 acc[2][2][4][2];
#pragma unroll
    for (int a = 0; a < 2; ++a)
#pragma unroll
        for (int b = 0; b < 2; ++b)
#pragma unroll
            for (int m = 0; m < 4; ++m)
#pragma unroll
                for (int n = 0; n < 2; ++n) acc[a][b][m][n] = (f32x4){0.f, 0.f, 0.f, 0.f};
    bf16x8 At[4][2], B0[2][2], B1[2][2];
    const char* cA = (const char*)g.A + (size_t)cur.pm * tstep; const char* cB = (const char*)g.Bt + (size_t)cur.pn * tstep;
    S.a_ready(cur);
    if constexpr (SP2) {
        PG8_STAGE(PG8_SB(0, 0), cB, voffB); PG8_STAGE(PG8_SB(0, 1), cB + hstep, voffB); PG8_STAGE(PG8_SA(0, 0), cA, voffA); PG8_STAGE(PG8_SA(0, 1), cA + hstep, voffA);
        if (wr == 1) PG8_BAR;
        PG8_WAIT_V(2); PG8_BAR;
        PG8_STAGE(PG8_SB(1, 0), cB + kstep, voffB); PG8_STAGE(PG8_SA(1, 0), cA + kstep, voffA); PG8_STAGE(PG8_SB(1, 1), cB + hstep + kstep, voffB);
        PG8_WAIT_V(6); PG8_BAR;
    } else {
        PG8_STAGE(PG8_SB(0, 0), cB, voffB); PG8_STAGE(PG8_SA(0, 0), cA, voffA); PG8_STAGE(PG8_SB(0, 1), cB + hstep, voffB); PG8_STAGE(PG8_SA(0, 1), cA + hstep, voffA);
        if (wr == 1) PG8_BAR;
        PG8_WAIT_V(4); PG8_BAR;
        PG8_STAGE(PG8_SB(1, 0), cB + kstep, voffB); PG8_STAGE(PG8_SA(1, 0), cA + kstep, voffA); PG8_STAGE(PG8_SB(1, 1), cB + hstep + kstep, voffB);
        PG8_WAIT_V(6); PG8_BAR;
    }
    for (;;) {
        const bool has_next = S.next(ui + 1, nxt);
        const char* nA = has_next ? (const char*)g.A + (size_t)nxt.pm * tstep : cA; const char* nB = has_next ? (const char*)g.Bt + (size_t)nxt.pn * tstep : cB;
        for (int t = 0; t < nt; t += 2) {
            const bool last = (t == nt - 2);
            const char* a1 = cA + (size_t)(t + 1) * kstep;
            const char* a2 = last ? nA : cA + (size_t)(t + 2) * kstep; const char* b2 = last ? nB : cB + (size_t)(t + 2) * kstep;
            const char* a3 = a2 + kstep; const char* b3 = b2 + kstep;
            if (last && has_next) S.a_ready(nxt);
            if constexpr (SP2) {
            PG8_LDB(B0, 0, 0); PG8_LDB(B1, 0, 1); PG8_SCHED; PG8_LDA(At, 0, 0); PG8_STAGE(PG8_SA(1, 1), a1 + hstep, voffA);
            PG8_WAIT_V(8); PG8_WAIT_L(0); PG8_BAR; PG8_MMA(0, 0, At, B0); PG8_MMA(0, 1, At, B1); PG8_BAR; PG8_SCHED;
            PG8_LDA(At, 0, 1); PG8_STAGE(PG8_SB(0, 0), b2, voffB); PG8_STAGE(PG8_SB(0, 1), b2 + hstep, voffB); PG8_STAGE(PG8_SA(0, 0), a2, voffA);
            PG8_WAIT_V(8); PG8_WAIT_L(0); PG8_BAR; PG8_MMA(1, 0, At, B0); PG8_MMA(1, 1, At, B1); PG8_BAR; PG8_SCHED;
            PG8_LDB(B0, 1, 0); PG8_LDB(B1, 1, 1); PG8_SCHED; PG8_LDA(At, 1, 0); PG8_STAGE(PG8_SA(0, 1), a2 + hstep, voffA);
            PG8_WAIT_V(8); PG8_WAIT_L(0); PG8_BAR; PG8_MMA(0, 0, At, B0); PG8_MMA(0, 1, At, B1); PG8_BAR; PG8_SCHED;
            PG8_LDA(At, 1, 1); PG8_STAGE(PG8_SB(1, 0), b3, voffB); PG8_STAGE(PG8_SB(1, 1), b3 + hstep, voffB); PG8_STAGE(PG8_SA(1, 0), a3, voffA);
            PG8_WAIT_V(8); PG8_WAIT_L(0); PG8_BAR; PG8_MMA(1, 0, At, B0); PG8_MMA(1, 1, At, B1); PG8_BAR; PG8_SCHED;
            } else {
            PG8_LDB(B0, 0, 0); PG8_SCHED; PG8_LDA(At, 0, 0); PG8_STAGE(PG8_SA(1, 1), a1 + hstep, voffA);
            PG8_WAIT_L(8); PG8_BAR; PG8_WAIT_L(0); PG8_MMA(0, 0, At, B0); PG8_BAR; PG8_SCHED;
            PG8_LDB(B1, 0, 1); PG8_STAGE(PG8_SB(0, 0), b2, voffB);
            PG8_BAR; PG8_WAIT_L(0); PG8_MMA(0, 1, At, B1); PG8_BAR;
            PG8_LDA(At, 0, 1); PG8_STAGE(PG8_SA(0, 0), a2, voffA);
            PG8_BAR; PG8_WAIT_L(0); PG8_MMA(1, 0, At, B0); PG8_BAR; PG8_SCHED;
            PG8_STAGE(PG8_SB(0, 1), b2 + hstep, voffB);
            PG8_WAIT_V(6); PG8_BAR; PG8_MMA(1, 1, At, B1); PG8_BAR;
            PG8_LDB(B0, 1, 0); PG8_SCHED; PG8_LDA(At, 1, 0); PG8_STAGE(PG8_SA(0, 1), a2 + hstep, voffA);
            PG8_WAIT_L(8); PG8_BAR; PG8_WAIT_L(0); PG8_MMA(0, 0, At, B0); PG8_BAR; PG8_SCHED;
            PG8_LDB(B1, 1, 1); PG8_STAGE(PG8_SB(1, 0), b3, voffB);
            PG8_BAR; PG8_WAIT_L(0); PG8_MMA(0, 1, At, B1); PG8_BAR;
            PG8_LDA(At, 1, 1); PG8_STAGE(PG8_SA(1, 0), a3, voffA);
            PG8_BAR; PG8_WAIT_L(0); PG8_MMA(1, 0, At, B0); PG8_BAR; PG8_SCHED;
            PG8_STAGE(PG8_SB(1, 1), b3 + hstep, voffB);
            PG8_WAIT_V(6); PG8_BAR; PG8_MMA(1, 1, At, B1); PG8_BAR;
            }
        }
        if constexpr (ALIGN_EPI) { if (wr == 0) PG8_BAR; }
        if constexpr (!Epi::AFTER_DRAIN) { E(acc, cur, wr, wc, fr, fq); S.done(cur); }
        if (!has_next) break;
#pragma unroll
        for (int a = 0; a < 2; ++a)
#pragma unroll
            for (int b = 0; b < 2; ++b)
#pragma unroll
                for (int m = 0; m < 4; ++m)
#pragma unroll
                    for (int n = 0; n < 2; ++n) acc[a][b][m][n] = (f32x4){0.f, 0.f, 0.f, 0.f};
        cur = nxt; cA = nA; cB = nB; ++ui;
        if constexpr (ALIGN_EPI) { if (wr == 1) PG8_BAR; }
    }
    PG8_WAIT_V(0);
    if constexpr (!ALIGN_EPI) { if (wr == 0) PG8_BAR; }
    PG8_BAR;
    if constexpr (Epi::AFTER_DRAIN) { E.fused(acc, cur, wr, wc, fr, fq, lds, wid, lane); S.done(cur); }
#undef PG8_SA
#undef PG8_SB
#undef PG8_STAGE
#undef PG8_LDA
#undef PG8_LDB
#undef PG8_MMA
#undef PG8_WAIT_V
#undef PG8_WAIT_L
#undef PG8_BAR
#undef PG8_SCHED
}
}
#define XB_TMO      128
#define XB_XCNT(j)  (256  + 64 * (j))
#define XB_XSUB(j)  (1280 + 64 * (j))
#define XB_XGEN(j)  (2304 + 64 * (j))
#define XB_TOP      3328
#define XB_TOPGEN   3392
#define XCD_BAR_WORDS 3456
#define XB_SPIN_CAP (1u << 18)

__device__ __forceinline__ unsigned xb_ld(unsigned* p)              { return __hip_atomic_load(p, __ATOMIC_RELAXED, __HIP_MEMORY_SCOPE_AGENT); }
__device__ __forceinline__ unsigned xb_add(unsigned* p, unsigned v) { return __hip_atomic_fetch_add(p, v, __ATOMIC_RELAXED, __HIP_MEMORY_SCOPE_AGENT); }
__device__ __forceinline__ unsigned xb_xcc_id() { return (unsigned)__builtin_amdgcn_s_getreg((3 << 11) | 20) & 0xFu; }
#define XB_SPIN(cond, bar) do { unsigned _sp = 0; while (cond) { __builtin_amdgcn_s_sleep(1); \
    if ((++_sp & 255u) == 0u) { if (xb_ld(&(bar)[XB_TMO])) break; if (_sp > XB_SPIN_CAP) { atomicAdd(&(bar)[XB_TMO], 1u); break; } } } } while (0)

struct XcdBarrier {
    unsigned* bar; unsigned x;
    volatile LAS unsigned* st;
};

__device__ __forceinline__ XcdBarrier xcd_barrier_post(unsigned* bar, volatile LAS unsigned* st) {
    XcdBarrier b; b.bar = bar; b.x = xb_xcc_id(); b.st = st;
    if (threadIdx.x == 0) (void)xb_add(&bar[XB_XCNT(b.x)], 1u);
    return b;
}
__device__ __forceinline__ void xcd_barrier_complete(unsigned* bar, unsigned x, unsigned& nloc, unsigned& nx) {
    const unsigned G = gridDim.x * gridDim.y * gridDim.z;
    unsigned sum, cnt, mine, sp = 0u;
    for (;;) {
        sum = 0u; cnt = 0u; mine = 0u;
#pragma unroll
        for (unsigned j = 0; j < 16; ++j) { const unsigned c = xb_ld(&bar[XB_XCNT(j)]); sum += c; cnt += (c > 0u) ? 1u : 0u; mine = (j == x) ? c : mine; }
        if (sum == G) break;
        __builtin_amdgcn_s_sleep(1);
        if ((++sp & 255u) == 0u) { if (xb_ld(&bar[XB_TMO])) break; if (sp > XB_SPIN_CAP) { atomicAdd(&bar[XB_TMO], 1u); break; } }
    }
    nloc = mine > 0u ? mine : 1u; nx = cnt > 0u ? cnt : 1u;
}

__device__ __forceinline__ void xcd_barrier(const XcdBarrier& b) {
    asm volatile("s_waitcnt vmcnt(0)" ::: "memory");
    __syncthreads();
    if (threadIdx.x == 0) {
        unsigned* bar = b.bar;
        __builtin_amdgcn_s_waitcnt(0);
        unsigned nloc = b.st[0], nx = b.st[1];
        if (nloc == 0u) { xcd_barrier_complete(bar, b.x, nloc, nx); b.st[0] = nloc; b.st[1] = nx; }
        const unsigned old = xb_add(&bar[XB_XSUB(b.x)], 1u);
        const unsigned gen = old / nloc;
        if (old + 1u == (gen + 1u) * nloc) {
            __builtin_amdgcn_fence(__ATOMIC_RELEASE, "agent");
            asm volatile("s_waitcnt vmcnt(0)" ::: "memory");
            const unsigned og = xb_add(&bar[XB_TOP], 1u);
            const unsigned tg = og / nx;
            if (og + 1u == (tg + 1u) * nx) xb_add(&bar[XB_TOPGEN], 1u);
            else XB_SPIN(xb_ld(&bar[XB_TOPGEN]) == tg, bar);
            __builtin_amdgcn_fence(__ATOMIC_ACQUIRE, "agent");
            xb_add(&bar[XB_XGEN(b.x)], 1u);
            asm volatile("s_waitcnt vmcnt(0)" ::: "memory");
        } else {
            XB_SPIN(xb_ld(&bar[XB_XGEN(b.x)]) == gen, bar);
            __builtin_amdgcn_fence(__ATOMIC_ACQUIRE, "agent");
            asm volatile("s_waitcnt vmcnt(0)" ::: "memory");
        }
    }
    __syncthreads();
}

typedef unsigned short bf16_t;
typedef short bf16x8 __attribute__((ext_vector_type(8)));
typedef float f32x4 __attribute__((ext_vector_type(4)));
typedef float f32x16 __attribute__((ext_vector_type(16)));
typedef unsigned u32x4 __attribute__((ext_vector_type(4)));
typedef unsigned u32x2 __attribute__((ext_vector_type(2)));
using pg8::cvtpk;
#define MFMA32(a, b, c) __builtin_amdgcn_mfma_f32_32x32x16_bf16((a), (b), (c), 0, 0, 0)
__device__ __forceinline__ float wave_sum(float v) {
#pragma unroll
    for (int o = 1; o < 64; o <<= 1) v += __shfl_xor(v, o);
    return v;
}
__device__ __forceinline__ float ex2(float x) { return __builtin_amdgcn_exp2f(x); }
__device__ __forceinline__ float lg2(float x) { return __builtin_amdgcn_logf(x); }

constexpr size_t MiB = 1u << 20;
constexpr size_t WS_ROPE = 1 * MiB;
constexpr size_t WS_WI = 2 * MiB, WS_WO = 8 * MiB, WS_WU = 10 * MiB, WS_WD = 18 * MiB;
constexpr size_t WS_HN = 26 * MiB;
constexpr size_t WS_Y = 58 * MiB;
constexpr size_t WS_QK = 58 * MiB;
constexpr size_t WS_U = 122 * MiB;
constexpr size_t WS_VTA = 122 * MiB, WS_VTB = 138 * MiB, WS_VTC = 146 * MiB;
constexpr size_t WS_OA = 154 * MiB;
constexpr size_t WS_CAT = 218 * MiB;
constexpr size_t WS_END = 250 * MiB;
static_assert(WS_VTB - WS_VTA == VTB_OFF * 2 && WS_VTC - WS_VTA == VTC_OFF * 2, "V^T offsets");

namespace att {
constexpr int KROW = 144;
constexpr int KBUF = 64 * KROW, VBUF = 128 * KROW;
constexpr int L_K0 = 0, L_K1 = KBUF, L_V0 = 2 * KBUF, L_V1 = 2 * KBUF + VBUF, L_MISC = 2 * KBUF + 2 * VBUF;
constexpr int L_RB = L_MISC, L_FLAG = L_MISC + 2048;

template <int DV> struct TileRegs { u32x4 k; u32x4 v[DV / 64]; };
template <int DV> __device__ __forceinline__ void tile_load(TileRegs<DV>& r, const bf16_t* Kb, const bf16_t* Vb, int key0, int tid) {
    const int row = tid >> 3, ch = tid & 7;
    r.k = *(const u32x4*)(Kb + (size_t)(key0 + row) * QKP + ch * 8);
#pragma unroll
    for (int i = 0; i < DV / 64; ++i) r.v[i] = *(const u32x4*)(Vb + (size_t)(row + 64 * i) * SEQ + key0 + ch * 8);
}
template <int DV> __device__ __forceinline__ void tile_store(const TileRegs<DV>& r, LAS unsigned char* lds, int kbuf, int vbuf, int tid) {
    const int row = tid >> 3, ch = tid & 7;
    *(LAS u32x4*)(lds + kbuf + row * KROW + ch * 16) = r.k;
#pragma unroll
    for (int i = 0; i < DV / 64; ++i) *(LAS u32x4*)(lds + vbuf + (row + 64 * i) * KROW + ch * 16) = r.v[i];
}
__device__ __forceinline__ void qk_tile(f32x16& s0, f32x16& s1, LAS const unsigned char* kp, const bf16x8 (&q)[4]) {
#pragma unroll
    for (int i = 0; i < 16; ++i) { s0[i] = 0.f; s1[i] = 0.f; }
#pragma unroll
    for (int d0 = 0; d0 < 4; ++d0) {
        const bf16x8 a0 = *(LAS const bf16x8*)(kp + d0 * 32), a1 = *(LAS const bf16x8*)(kp + 32 * KROW + d0 * 32);
        s0 = MFMA32(a0, q[d0], s0); s1 = MFMA32(a1, q[d0], s1);
    }
}
__device__ __forceinline__ bf16x8 pack8(const f32x16& s, int b) {
    u32x4 w; w.x = cvtpk(s[b], s[b + 1]); w.y = cvtpk(s[b + 2], s[b + 3]); w.z = cvtpk(s[b + 4], s[b + 5]); w.w = cvtpk(s[b + 6], s[b + 7]);
    return __builtin_bit_cast(bf16x8, w);
}
template <int NDB> __device__ __forceinline__ void pv_tile(f32x16 (&o)[NDB], LAS const unsigned char* vp, const bf16x8 (&pf)[4]) {
#pragma unroll
    for (int db = 0; db < NDB; ++db)
#pragma unroll
        for (int kg = 0; kg < 4; ++kg) { const bf16x8 a = *(LAS const bf16x8*)(vp + db * 32 * KROW + kg * 32); o[db] = MFMA32(a, pf[kg], o[db]); }
}
template <int NDB> __device__ __forceinline__ void softmax_update(f32x16& s0, f32x16& s1, float& m, float& l, f32x16 (&o)[NDB], LAS const unsigned char* vp) {
    float mx = fmaxf(s0[0], s1[0]);
#pragma unroll
    for (int i = 1; i < 16; ++i) mx = fmaxf(mx, fmaxf(s0[i], s1[i]));
    mx = fmaxf(mx, __shfl_xor(mx, 32));
    const float mn = fmaxf(m, mx), alpha = ex2(m - mn); m = mn;
    float ps = 0.f;
#pragma unroll
    for (int i = 0; i < 16; ++i) { s0[i] = ex2(s0[i] - mn); s1[i] = ex2(s1[i] - mn); ps += s0[i] + s1[i]; }
    l = l * alpha + ps;
#pragma unroll
    for (int db = 0; db < NDB; ++db) o[db] = o[db] * alpha;
    bf16x8 pf[4]; pf[0] = pack8(s0, 0); pf[1] = pack8(s0, 8); pf[2] = pack8(s1, 0); pf[3] = pack8(s1, 8);
    pv_tile<NDB>(o, vp, pf);
}
struct Lane { int tid, wid, lane, rho, hi, koff, voff; };
__device__ __forceinline__ Lane make_lane() {
    Lane L; L.tid = fresh_tid(); L.wid = __builtin_amdgcn_readfirstlane(L.tid >> 6); L.lane = L.tid & 63; L.rho = L.lane & 31; L.hi = L.lane >> 5;
    const int pr = (L.rho & ~12) | ((L.rho & 4) << 1) | ((L.rho & 8) >> 1);
    L.koff = pr * KROW + L.hi * 16; L.voff = L.rho * KROW + L.hi * 16; return L;
}
__device__ __forceinline__ void load_q(bf16x8 (&q)[4], const bf16_t* Qrow  ) {
#pragma unroll
    for (int d0 = 0; d0 < 4; ++d0) q[d0] = *(const bf16x8*)(Qrow + d0 * 16);
}

__device__ __forceinline__ void attnA_item(LAS unsigned char* lds, const Lane& L, const bf16_t* QK, const bf16_t* VTa, float* OA, int b, int h, int n, int qblk) {
    const int rowq = qblk * 256 + L.wid * 32, cw = rowq >> 6;
    const size_t tok0 = (size_t)b * SEQ;
    bf16x8 q[4]; load_q(q, QK + (tok0 + rowq + L.rho) * QKP + h * 128 + n * 64 + L.hi * 8);
    const bf16_t* Kb = QK + tok0 * QKP + 512 + h * 128 + n * 64;
    const bf16_t* Vb = VTa + (size_t)((b * 4 + h) * 128) * SEQ;
    const int NT = 4 * qblk + 4;
    TileRegs<128> tr;
    tile_load<128>(tr, Kb, Vb, 0, L.tid); tile_store<128>(tr, lds, L_K0, L_V0, L.tid); __syncthreads();
    float m = -1e30f, l = 0.f; f32x16 o[4];
#pragma unroll
    for (int db = 0; db < 4; ++db)
#pragma unroll
        for (int i = 0; i < 16; ++i) o[db][i] = 0.f;
    for (int t = 0; t < NT; ++t) {
        const int cur = t & 1;
        if (t + 1 < NT) tile_load<128>(tr, Kb, Vb, (t + 1) * 64, L.tid);
        if (t <= cw) {
            f32x16 s0, s1; qk_tile(s0, s1, lds + (cur ? L_K1 : L_K0) + L.koff, q);
            softmax_update<4>(s0, s1, m, l, o, lds + (cur ? L_V1 : L_V0) + L.voff);
        }
        if (t + 1 < NT) tile_store<128>(tr, lds, cur ? L_K0 : L_K1, cur ? L_V0 : L_V1, L.tid);
        __syncthreads();
    }
    l += __shfl_xor(l, 32);
    const float inv = 1.0f / l;
    float* op = OA + ((size_t)n * NTOK + tok0 + rowq + L.rho) * 512 + h * 128 + 4 * L.hi;
#pragma unroll
    for (int db = 0; db < 4; ++db)
#pragma unroll
        for (int g = 0; g < 4; ++g) { f32x4 v = {o[db][4 * g], o[db][4 * g + 1], o[db][4 * g + 2], o[db][4 * g + 3]}; *(f32x4*)(op + db * 32 + 8 * g) = v * inv; }
}
__device__ __forceinline__ void store_head_norm(const f32x16 (&o)[2], const Lane& L, const float* gain  , bf16_t* dst  ) {
    float ss = 0.f;
#pragma unroll
    for (int db = 0; db < 2; ++db)
#pragma unroll
        for (int i = 0; i < 16; ++i) ss += o[db][i] * o[db][i];
    ss += __shfl_xor(ss, 32);
    const float rs = rsqrtf(ss * (1.0f / 64.0f) + RMS_EPS);
#pragma unroll
    for (int db = 0; db < 2; ++db)
#pragma unroll
        for (int g = 0; g < 4; ++g) { const int d = db * 32 + 8 * g + 4 * L.hi; const f32x4 gv = *(const f32x4*)(gain + d);
            u32x2 w; w.x = cvtpk(o[db][4 * g] * rs * gv[0], o[db][4 * g + 1] * rs * gv[1]); w.y = cvtpk(o[db][4 * g + 2] * rs * gv[2], o[db][4 * g + 3] * rs * gv[3]);
            *(u32x2*)(dst + d) = w; }
}
__device__ __forceinline__ void attnB_item(LAS unsigned char* lds, const Lane& L, const bf16_t* QK, const bf16_t* VTb, bf16_t* CAT, const float* relb  , const float* gnb, int b, int h, int qblk) {
    const int rowq = qblk * 256 + L.wid * 32, cw = rowq >> 6;
    const size_t tok0 = (size_t)b * SEQ;
    LAS float* rb = (LAS float*)(lds + L_RB);
    if (L.tid < 257) rb[L.tid] = relb[h * 257 + L.tid] * LOG2E;
    bf16x8 q[4]; load_q(q, QK + (tok0 + rowq + L.rho) * QKP + 1024 + h * 64 + L.hi * 8);
    const bf16_t* Kb = QK + tok0 * QKP + 1280 + h * 64;
    const bf16_t* Vb = VTb + (size_t)((b * 4 + h) * 64) * SEQ;
    const int t_lo = (4 * qblk - 8) > 0 ? (4 * qblk - 8) : 0, t_hi = 4 * qblk + 3;
    TileRegs<64> tr;
    tile_load<64>(tr, Kb, Vb, t_lo * 64, L.tid); tile_store<64>(tr, lds, L_K0, L_V0, L.tid); __syncthreads();
    float m = -1e30f, l = 0.f; f32x16 o[2];
#pragma unroll
    for (int db = 0; db < 2; ++db)
#pragma unroll
        for (int i = 0; i < 16; ++i) o[db][i] = 0.f;
    const int qpos = rowq + L.rho;
    for (int t = t_lo; t <= t_hi; ++t) {
        const int cur = (t - t_lo) & 1;
        if (t < t_hi) tile_load<64>(tr, Kb, Vb, (t + 1) * 64, L.tid);
        if (t <= cw && t >= cw - 8) {
            f32x16 s0, s1; qk_tile(s0, s1, lds + (cur ? L_K1 : L_K0) + L.koff, q);
            if (cw - t >= 3) {
                const float bc = rb[256];
#pragma unroll
                for (int i = 0; i < 16; ++i) { s0[i] += bc; s1[i] += bc; }
            } else {
                const int rel0 = qpos - (t * 64 + 8 * L.hi);
#pragma unroll
                for (int r = 0; r < 16; ++r) { const int ko = 16 * (r >> 3) + (r & 7);
                    int i0 = rel0 - ko; i0 = (i0 > 128 ? 128 : i0) + 128; int i1 = rel0 - 32 - ko; i1 = (i1 > 128 ? 128 : i1) + 128;
                    s0[r] += rb[i0]; s1[r] += rb[i1]; }
            }
            softmax_update<2>(s0, s1, m, l, o, lds + (cur ? L_V1 : L_V0) + L.voff);
        }
        if (t < t_hi) tile_store<64>(tr, lds, cur ? L_K0 : L_K1, cur ? L_V0 : L_V1, L.tid);
        __syncthreads();
    }
    l += __shfl_xor(l, 32);
    const float inv = 1.0f / l;
#pragma unroll
    for (int db = 0; db < 2; ++db) o[db] = o[db] * inv;
    store_head_norm(o, L, gnb + h * 64, CAT + (tok0 + rowq + L.rho) * 1024 + 512 + h * 64);
}
__device__ __forceinline__ void stick_block(const f32x16& y, int kbase, int lim, int hi, float& R, bf16x8& pf0, bf16x8& pf1) {
    f32x16 ls, lb;
#pragma unroll
    for (int r = 0; r < 16; ++r) {
        const int kpos = kbase + 16 * (r >> 3) + 8 * hi + (r & 7);
        const float yy = y[r], sp = fmaxf(yy, 0.f) + lg2(1.0f + ex2(-fabsf(yy)));
        const bool valid = kpos < lim;
        ls[r] = valid ? -sp : 0.f;
        lb[r] = valid ? (yy - sp) : -1e30f;
    }
    float g0 = 0.f, g1 = 0.f;
#pragma unroll
    for (int i = 0; i < 8; ++i) { g0 += ls[i]; g1 += ls[8 + i]; }
    const float p0 = __shfl_xor(g0, 32), p1 = __shfl_xor(g1, 32);
    const float G11 = hi ? g1 : p1, G01 = hi ? p1 : g1, G10 = hi ? g0 : p0, G00 = hi ? p0 : g0;
    float run1 = R + (hi ? 0.f : G11);
    float run0 = R + (G11 + G01) + (hi ? 0.f : G10);
    f32x16 a;
#pragma unroll
    for (int i = 7; i >= 0; --i) {
        a[8 + i] = ex2(lb[8 + i] + run1); run1 += ls[8 + i];
        a[i] = ex2(lb[i] + run0); run0 += ls[i];
    }
    R += (G11 + G01) + (G10 + G00);
    pf0 = pack8(a, 0); pf1 = pack8(a, 8);
}
__device__ __forceinline__ void attnC_item(LAS unsigned char* lds, const Lane& L, const bf16_t* QK, const bf16_t* VTc, bf16_t* CAT, const float* gnc, int b, int h, int qblk) {
    const int rowq = qblk * 256 + L.wid * 32, cw = rowq >> 6;
    const size_t tok0 = (size_t)b * SEQ;
    volatile LAS unsigned* flag = (volatile LAS unsigned*)(lds + L_FLAG);
    bf16x8 q[4]; load_q(q, QK + (tok0 + rowq + L.rho) * QKP + 1536 + h * 64 + L.hi * 8);
    const bf16_t* Kb = QK + tok0 * QKP + 1792 + h * 64;
    const bf16_t* Vb = VTc + (size_t)((b * 4 + h) * 64) * SEQ;
    const int t_hi = 4 * qblk + 3;
    TileRegs<64> tr;
    tile_load<64>(tr, Kb, Vb, t_hi * 64, L.tid); tile_store<64>(tr, lds, L_K0, L_V0, L.tid); __syncthreads();
    float R = 0.f; f32x16 o[2];
#pragma unroll
    for (int db = 0; db < 2; ++db)
#pragma unroll
        for (int i = 0; i < 16; ++i) o[db][i] = 0.f;
    const int qpos = rowq + L.rho;
    bool wdone = false;
    for (int t = t_hi; t >= 0; --t) {
        const int it = t_hi - t, cur = it & 1;
        if (t > 0) tile_load<64>(tr, Kb, Vb, (t - 1) * 64, L.tid);
        if (t <= cw && !wdone) {
            f32x16 s0, s1; qk_tile(s0, s1, lds + (cur ? L_K1 : L_K0) + L.koff, q);
            const int lim = (t == cw) ? qpos : 0x7fffffff;
            bf16x8 pf[4];
            stick_block(s1, t * 64 + 32, lim, L.hi, R, pf[2], pf[3]);
            stick_block(s0, t * 64, lim, L.hi, R, pf[0], pf[1]);
            pv_tile<2>(o, lds + (cur ? L_V1 : L_V0) + L.voff, pf);
            wdone = __all(R < -150.0f) != 0;
        }
        if (L.lane == 0) flag[cur * 8 + L.wid] = (wdone || t == 0) ? 1u : 0u;
        if (t > 0) tile_store<64>(tr, lds, cur ? L_K0 : L_K1, cur ? L_V0 : L_V1, L.tid);
        __syncthreads();
        unsigned alld = 1u;
#pragma unroll
        for (int w = 0; w < 8; ++w) alld &= flag[cur * 8 + w];
        if (alld) break;
    }
    __syncthreads();
    store_head_norm(o, L, gnc + h * 64, CAT + (tok0 + rowq + L.rho) * 1024 + 768 + h * 64);
}
}

__device__ __forceinline__ void store_row_bf16(bf16_t* orow, const f32x4 (&v)[4], int lane) {
#pragma unroll
    for (int j = 0; j < 4; ++j) { u32x2 w; w.x = cvtpk(v[j][0], v[j][1]); w.y = cvtpk(v[j][2], v[j][3]); *((u32x2*)orow + lane + 64 * j) = w; }
}
__device__ __forceinline__ void prenorm_pass(const float* x, const float* g, bf16_t* HN, int gw, int NGW, int lane) {
    for (int m = gw; m < NTOK; m += NGW) {
        const f32x4* xr = (const f32x4*)(x + (size_t)m * DM) + lane; f32x4 v[4]; float s = 0.f;
#pragma unroll
        for (int j = 0; j < 4; ++j) { v[j] = xr[64 * j]; s += (v[j][0] * v[j][0] + v[j][1] * v[j][1]) + (v[j][2] * v[j][2] + v[j][3] * v[j][3]); }
        const float rs = rsqrtf(wave_sum(s) * (1.0f / DM) + RMS_EPS);
#pragma unroll
        for (int j = 0; j < 4; ++j) v[j] = v[j] * rs * ((const f32x4*)g)[lane + 64 * j];
        store_row_bf16(HN + (size_t)m * DM, v, lane);
    }
}
__device__ __forceinline__ void postnorm_pass(const bf16_t* Y, const float* xin, float* xout, const float* gpost, const float* gnext, bf16_t* HN, int gw, int NGW, int lane) {
    for (int m = gw; m < NTOK; m += NGW) {
        const u32x2* yr = (const u32x2*)(Y + (size_t)m * DM) + lane; const f32x4* xr = (const f32x4*)(xin + (size_t)m * DM) + lane;
        f32x4 y[4], v[4]; float s = 0.f;
#pragma unroll
        for (int j = 0; j < 4; ++j) { const u32x2 w = yr[64 * j]; v[j] = xr[64 * j];
            y[j][0] = __uint_as_float(w.x << 16); y[j][1] = __uint_as_float(w.x & 0xffff0000u); y[j][2] = __uint_as_float(w.y << 16); y[j][3] = __uint_as_float(w.y & 0xffff0000u);
            s += (y[j][0] * y[j][0] + y[j][1] * y[j][1]) + (y[j][2] * y[j][2] + y[j][3] * y[j][3]); }
        const float rs = rsqrtf(wave_sum(s) * (1.0f / DM) + RMS_EPS);
        float s2 = 0.f;
#pragma unroll
        for (int j = 0; j < 4; ++j) { v[j] = v[j] + y[j] * rs * ((const f32x4*)gpost)[lane + 64 * j]; s2 += (v[j][0] * v[j][0] + v[j][1] * v[j][1]) + (v[j][2] * v[j][2] + v[j][3] * v[j][3]); }
        f32x4* xo = (f32x4*)(xout + (size_t)m * DM) + lane;
#pragma unroll
        for (int j = 0; j < 4; ++j) xo[64 * j] = v[j];
        if (gnext) {
            const float rs2 = rsqrtf(wave_sum(s2) * (1.0f / DM) + RMS_EPS);
#pragma unroll
            for (int j = 0; j < 4; ++j) v[j] = v[j] * rs2 * ((const f32x4*)gnext)[lane + 64 * j];
            store_row_bf16(HN + (size_t)m * DM, v, lane);
        }
    }
}
__device__ __forceinline__ void combine_pass(const float* OA, bf16_t* CAT, const float* subln, float lam, float oscale, int gw, int NGW, int lane) {
    const int e0 = (lane & 15) * 8;
    const f32x4 g0 = *(const f32x4*)(subln + e0), g1 = *(const f32x4*)(subln + e0 + 4);
    for (int m = gw; m < NTOK; m += NGW) {
        const f32x4* a = (const f32x4*)(OA + (size_t)m * 512) + 2 * lane; const f32x4* c = (const f32x4*)(OA + ((size_t)NTOK + m) * 512) + 2 * lane;
        f32x4 d0 = a[0] - c[0] * lam, d1 = a[1] - c[1] * lam;
        float ss = (d0[0] * d0[0] + d0[1] * d0[1]) + (d0[2] * d0[2] + d0[3] * d0[3]) + (d1[0] * d1[0] + d1[1] * d1[1]) + (d1[2] * d1[2] + d1[3] * d1[3]);
#pragma unroll
        for (int o = 1; o < 16; o <<= 1) ss += __shfl_xor(ss, o);
        const float rs = rsqrtf(ss * (1.0f / 128.0f) + RMS_EPS) * oscale;
        d0 = d0 * rs * g0; d1 = d1 * rs * g1;
        u32x4 w; w.x = cvtpk(d0[0], d0[1]); w.y = cvtpk(d0[2], d0[3]); w.z = cvtpk(d1[0], d1[1]); w.w = cvtpk(d1[2], d1[3]);
        *((u32x4*)(CAT + (size_t)m * 1024) + lane) = w;
    }
}
__device__ __forceinline__ void transpose_item(const float* W, int K, int N, bf16_t* WT, LAS float* scr, int item, int lane) {
    const int nblk = N / 32, kb = item / nblk, nb = item % nblk, k0 = 64 * kb, n0 = 32 * nb;
#pragma unroll 8
    for (int i = 0; i < 32; ++i) { const int kk = 2 * i + (lane >> 5); scr[kk * 33 + (lane & 31)] = W[(size_t)(k0 + kk) * N + n0 + (lane & 31)]; }
    asm volatile("s_waitcnt lgkmcnt(0)" ::: "memory");
    const int c = lane & 7;
#pragma unroll
    for (int j = 0; j < 4; ++j) { const int n = (lane >> 3) + 8 * j; const LAS float* s = scr + (8 * c) * 33 + n;
        u32x4 o; o.x = cvtpk(s[0 * 33], s[1 * 33]); o.y = cvtpk(s[2 * 33], s[3 * 33]); o.z = cvtpk(s[4 * 33], s[5 * 33]); o.w = cvtpk(s[6 * 33], s[7 * 33]);
        *(u32x4*)(WT + (size_t)(n0 + n) * K + k0 + 8 * c) = o; }
    asm volatile("s_waitcnt lgkmcnt(0)" ::: "memory");
}

struct Args {
    const float* x; const float* g_pre_mix; const float* w_in; const float* lq1; const float* lk1; const float* lq2; const float* lk2;
    const float* subln; const float* relb; const float* gnb; const float* gnc; const float* w_out; const float* g_post_mix; const float* g_pre_mlp;
    const float* w_up; const float* w_down; const float* g_post_mlp;
    float* out; unsigned char* ws;
    float inv_freq[8]; float lam_init[2]; int ph_lo, ph_hi, coop, pad;
};
constexpr int NPHASE = 1 + 8 * NLAYER;
constexpr int LDS_BYTES = 147456;

__device__ __forceinline__ void convert_weights(const Args& a, int l, LAS unsigned char* lds, int gw, int NGW, int wave, int lane) {
    LAS float* scr = (LAS float*)(lds + wave * 16384);
    constexpr int I_IN = (DM / 64) * (DIN / 32), I_O = (DM / 64) * (DM / 32), I_U = (DM / 64) * (DFF / 32), I_D = (DFF / 64) * (DM / 32);
    constexpr int NITEMS = I_IN + I_O + I_U + I_D;
    bf16_t* Wi = (bf16_t*)(a.ws + WS_WI); bf16_t* Wo = (bf16_t*)(a.ws + WS_WO); bf16_t* Wu = (bf16_t*)(a.ws + WS_WU); bf16_t* Wd = (bf16_t*)(a.ws + WS_WD);
    for (int it = gw; it < NITEMS; it += NGW) {
        int r = it;
        if (r < I_IN) { transpose_item(a.w_in + (size_t)l * DM * DIN, DM, DIN, Wi, scr, r, lane); continue; } r -= I_IN;
        if (r < I_O) { transpose_item(a.w_out + (size_t)l * DM * DM, DM, DM, Wo, scr, r, lane); continue; } r -= I_O;
        if (r < I_U) { transpose_item(a.w_up + (size_t)l * DM * DFF, DM, DFF, Wu, scr, r, lane); continue; } r -= I_U;
        transpose_item(a.w_down + (size_t)l * DFF * DM, DFF, DM, Wd, scr, r, lane);
    }
}

__global__ void __launch_bounds__(512, 2) mk_fwd(Args a) {
    extern __shared__ __attribute__((aligned(16))) unsigned char lds_raw[];
    LAS unsigned char* lds = (LAS unsigned char*)lds_raw;
    cg::grid_group grid = cg::this_grid();
    const int G = gridDim.x, bx = blockIdx.x;
    const int vcu = (G % 8 == 0) ? (bx % 8) * (G / 8) + bx / 8 : bx;
    const int NGW = G * 8;
#define FRESH_IDS() const int tid = fresh_tid(), lane = tid & 63, wave = __builtin_amdgcn_readfirstlane(tid >> 6), gw = vcu * 8 + wave; (void)tid; (void)lane; (void)gw
    unsigned char* ws = a.ws;
    bf16_t* Wi = (bf16_t*)(ws + WS_WI); bf16_t* Wo = (bf16_t*)(ws + WS_WO); bf16_t* Wu = (bf16_t*)(ws + WS_WU); bf16_t* Wd = (bf16_t*)(ws + WS_WD);
    bf16_t* HN = (bf16_t*)(ws + WS_HN); bf16_t* Y = (bf16_t*)(ws + WS_Y); bf16_t* QK = (bf16_t*)(ws + WS_QK); bf16_t* U = (bf16_t*)(ws + WS_U);
    bf16_t* VTa = (bf16_t*)(ws + WS_VTA); bf16_t* VTb = (bf16_t*)(ws + WS_VTB); bf16_t* VTc = (bf16_t*)(ws + WS_VTC);
    float* OA = (float*)(ws + WS_OA); bf16_t* CAT = (bf16_t*)(ws + WS_CAT); float* rope = (float*)(ws + WS_ROPE);

    const int lo = a.ph_lo, hi = a.ph_hi;
    volatile LAS unsigned* bst = (volatile LAS unsigned*)(lds + LDS_BYTES - 64);
    if (threadIdx.x < 16) bst[threadIdx.x] = 0u;
    __syncthreads();
    XcdBarrier bar; bar.bar = (unsigned*)ws; bar.x = 0; bar.st = bst;
    if (a.coop) bar = xcd_barrier_post((unsigned*)ws, bst);
    if (a.pad == 0x7fffffff) grid.sync();
#define IN(p) (lo <= (p) && (p) < hi)
#define SEAM(p) do { if (IN((p) + 1) && a.coop) xcd_barrier(bar); } while (0)
    if (IN(0)) {
        FRESH_IDS();
        convert_weights(a, 0, lds, gw, NGW, wave, lane);
        for (int p = bx * 512 + tid; p < SEQ; p += G * 512) {
            f32x4 c[2], s[2];
#pragma unroll
            for (int j = 0; j < 8; ++j) {
                const float ang = (float)p * a.inv_freq[j];
                double t = (double)ang * 0.15915494309189535; t -= rint(t);
                const float tf = (float)t;
                c[j >> 2][j & 3] = __builtin_amdgcn_cosf(tf); s[j >> 2][j & 3] = __builtin_amdgcn_sinf(tf);
            }
            f32x4* o = (f32x4*)(rope + (size_t)p * 16); o[0] = c[0]; o[1] = c[1]; o[2] = s[0]; o[3] = s[1];
        }
        prenorm_pass(a.x, a.g_pre_mix, HN, gw, NGW, lane);
        SEAM(0);
    }
    for (int l = 0; l < NLAYER; ++l) {
        const int p0 = 1 + 8 * l;
        if (IN(p0)) {
            pg8::Gemm g{HN, Wi, NTOK, DIN, DM}; pg8::StaticOrder S; S.init(NTOK, DIN, G, bx);
            pg8::EpiProj E{QK, VTa, rope};
            for (int rep = 0; rep < PROBE_REP_G; ++rep) pg8::gemm_phase<pg8::EpiProj, pg8::StaticOrder, true, true>(lds, g, S, E);
            SEAM(p0);
        }
        if (IN(p0 + 1)) {
            const att::Lane L = att::make_lane();
            for (int rep = 0; rep < PROBE_REP_A; ++rep)
            for (int it = vcu; it < 256; it += G) {
                const int combo = it >> 3, s = it & 7, b = combo >> 3, h = (combo >> 1) & 3, n = combo & 1;
                att::attnA_item(lds, L, QK, VTa, OA, b, h, n, 15 - s);
                att::attnA_item(lds, L, QK, VTa, OA, b, h, n, s);
            }
            for (int rep = 0; rep < PROBE_REP_B; ++rep)
            for (int it = vcu; it < 256; it += G) {
                const int b = it >> 6, h = (it >> 4) & 3, qblk = it & 15;
                att::attnB_item(lds, L, QK, VTb, CAT, a.relb + (size_t)l * 4 * 257, a.gnb + l * 256, b, h, qblk);
            }
            for (int rep = 0; rep < PROBE_REP_C; ++rep)
            for (int it = vcu; it < 256; it += G) {
                const int b = it >> 6, h = (it >> 4) & 3, qblk = it & 15;
                att::attnC_item(lds, L, QK, VTc, CAT, a.gnc + l * 256, b, h, qblk);
            }
            SEAM(p0 + 1);
        }
        if (IN(p0 + 2)) {
            FRESH_IDS();
            const float li = (l == 0) ? a.lam_init[0] : a.lam_init[1];
            const float s1 = wave_sum(a.lq1[l * 64 + lane] * a.lk1[l * 64 + lane]), s2 = wave_sum(a.lq2[l * 64 + lane] * a.lk2[l * 64 + lane]);
            const float lam = expf(s1) - expf(s2) + li;
            combine_pass(OA, CAT, a.subln + l * 128, lam, 1.0f - li, gw, NGW, lane);
            SEAM(p0 + 2);
        }
        if (IN(p0 + 3)) {
            pg8::Gemm g{CAT, Wo, NTOK, DM, DM}; pg8::StaticOrder S; S.init(NTOK, DM, G, bx);
            pg8::EpiY E{Y, DM};
            for (int rep = 0; rep < PROBE_REP_G; ++rep) pg8::gemm_phase<pg8::EpiY, pg8::StaticOrder, true, true>(lds, g, S, E);
            SEAM(p0 + 3);
        }
        if (IN(p0 + 4)) {
            FRESH_IDS();
            postnorm_pass(Y, l == 0 ? a.x : a.out, a.out, a.g_post_mix + l * DM, a.g_pre_mlp + l * DM, HN, gw, NGW, lane);
            SEAM(p0 + 4);
        }
        if (IN(p0 + 5)) {
            pg8::Gemm g{HN, Wu, NTOK, DFF, DM}; pg8::StaticOrder S; S.init(NTOK, DFF, G, bx);
            pg8::EpiRelu2 E{U, DFF};
            for (int rep = 0; rep < PROBE_REP_G; ++rep) pg8::gemm_phase<pg8::EpiRelu2, pg8::StaticOrder, true, true>(lds, g, S, E);
            SEAM(p0 + 5);
        }
        if (IN(p0 + 6)) {
            pg8::Gemm g{U, Wd, NTOK, DM, DFF}; pg8::StaticOrder S; S.init(NTOK, DM, G, bx);
            pg8::EpiY E{Y, DM};
            for (int rep = 0; rep < PROBE_REP_G; ++rep) pg8::gemm_phase<pg8::EpiY, pg8::StaticOrder, true, true>(lds, g, S, E);
            SEAM(p0 + 6);
        }
        if (IN(p0 + 7)) {
            FRESH_IDS();
            postnorm_pass(Y, a.out, a.out, a.g_post_mlp + l * DM, (l + 1 < NLAYER) ? a.g_pre_mix + (l + 1) * DM : nullptr, HN, gw, NGW, lane);
            if (l + 1 < NLAYER) convert_weights(a, l + 1, lds, gw, NGW, wave, lane);
            SEAM(p0 + 7);
        }
    }
#undef IN
#undef SEAM
}

extern "C" void kernel_launch(void* const* d_in, const int* in_sizes, int n_in, void* d_out, int out_size, void* d_ws, size_t ws_size, hipStream_t stream) {
    static int grid_blocks = 0;
    if (grid_blocks == 0) {
        if (n_in != 17 || ws_size < WS_END) { fprintf(stderr, "kernel_launch: unexpected inputs (n_in %d, ws %zu)\n", n_in, ws_size); grid_blocks = -1; return; }
        int dev = 0, cus = 0, per_cu = 0;
        hipGetDevice(&dev);
        hipDeviceGetAttribute(&cus, hipDeviceAttributeMultiprocessorCount, dev);
        if (hipFuncSetAttribute((const void*)mk_fwd, hipFuncAttributeMaxDynamicSharedMemorySize, LDS_BYTES) != hipSuccess) fprintf(stderr, "kernel_launch: hipFuncSetAttribute failed\n");
        if (hipOccupancyMaxActiveBlocksPerMultiprocessor(&per_cu, (const void*)mk_fwd, 512, LDS_BYTES) != hipSuccess || per_cu < 1) { fprintf(stderr, "kernel_launch: occupancy query gave %d\n", per_cu); per_cu = 1; }
        (void)hipGetLastError();
        grid_blocks = cus * per_cu;
        if (grid_blocks % 8 != 0 || grid_blocks > 1024) grid_blocks = cus;
    }
    if (grid_blocks < 0) return;
    if (hipMemsetAsync(d_ws, 0, 16384, stream) != hipSuccess) fprintf(stderr, "kernel_launch: hipMemsetAsync failed\n");
    Args a{};
    a.x = (const float*)d_in[0]; a.g_pre_mix = (const float*)d_in[1]; a.w_in = (const float*)d_in[2]; a.lq1 = (const float*)d_in[3]; a.lk1 = (const float*)d_in[4];
    a.lq2 = (const float*)d_in[5]; a.lk2 = (const float*)d_in[6]; a.subln = (const float*)d_in[7]; a.relb = (const float*)d_in[8]; a.gnb = (const float*)d_in[9];
    a.gnc = (const float*)d_in[10]; a.w_out = (const float*)d_in[11]; a.g_post_mix = (const float*)d_in[12]; a.g_pre_mlp = (const float*)d_in[13];
    a.w_up = (const float*)d_in[14]; a.w_down = (const float*)d_in[15]; a.g_post_mlp = (const float*)d_in[16];
    a.out = (float*)d_out; a.ws = (unsigned char*)d_ws;
    for (int j = 0; j < 8; ++j) a.inv_freq[j] = powf(500000.0f, -(float)(2 * j) / 16.0f);
    for (int l = 0; l < 2; ++l) a.lam_init[l] = (float)(0.8 - 0.6 * exp(-0.3 * (double)l));
    a.pad = 0;
#if MK_SPLIT
    a.coop = 0;
    for (int ph = 0; ph < NPHASE; ++ph) { a.ph_lo = ph; a.ph_hi = ph + 1; hipLaunchKernelGGL(mk_fwd, dim3(grid_blocks), dim3(512), LDS_BYTES, stream, a); }
#else
    a.coop = 1; a.ph_lo = 0; a.ph_hi = NPHASE;
    void* args[] = {&a};
    hipError_t e = hipLaunchCooperativeKernel((const void*)mk_fwd, dim3(grid_blocks), dim3(512), args, LDS_BYTES, stream);
    if (e != hipSuccess) fprintf(stderr, "cooperative launch failed: %s (grid %d)\n", hipGetErrorString(e), grid_blocks);
#endif
}
```

```cpp
#include <hip/hip_runtime.h>
#include <hip/hip_cooperative_groups.h>
#include <cstdio>
#include <cstdint>
#include <cmath>
namespace cg = cooperative_groups;
#ifndef MK_SPLIT
#define MK_SPLIT 0
#endif

#ifndef PROBE_REP_A
#define PROBE_REP_A 1
#endif
#ifndef PROBE_REP_B
#define PROBE_REP_B 1
#endif
#ifndef PROBE_REP_C
#define PROBE_REP_C 1
#endif
#ifndef PROBE_REP_G
#define PROBE_REP_G 1
#endif
#ifndef PROBE_PASS
#define PROBE_PASS 0
#endif
constexpr int SEQ = 4096, NBATCH = 4, DM = 1024, DFF = 4096, DIN = 3072, NTOK = NBATCH * SEQ, NLAYER = 2;
constexpr int QKP = 2048;
constexpr size_t VTB_OFF = (size_t)8 << 20, VTC_OFF = (size_t)12 << 20;
constexpr float RMS_EPS = 1e-6f;
constexpr float LOG2E = 1.4426950408889634f;
constexpr float QSCALE = 0.125f * LOG2E;

#define LAS __attribute__((address_space(3)))
__device__ __forceinline__ int fresh_tid() { int t = threadIdx.x; asm volatile("" : "+v"(t)); return t; }

namespace pg8 {
#define PG8_LAS __attribute__((address_space(3)))
typedef unsigned short bf16_t;
typedef short bf16x8 __attribute__((ext_vector_type(8)));
typedef float f32x4 __attribute__((ext_vector_type(4)));
typedef unsigned u32x4 __attribute__((ext_vector_type(4)));
constexpr int BM = 256, BK = 64, HALF = 128, HTB = HALF * BK * 2  , STAGE_BYTES = 8 * HTB, NXCD = 8, WGM = 8;

__host__ __device__ __forceinline__ int lds_byte(int r, int c) { const int st = (r >> 4) * 2 + (c >> 5), rr = r & 15, cc = c & 31, ob = rr * 64 + cc * 2; return st * 1024 + (ob ^ (((ob >> 9) & 1) << 5)); }
__host__ __device__ __forceinline__ void stage_rc(int b, int& R, int& C) { const int st = b / 1024, sb = b % 1024, swz = sb ^ (((sb >> 9) & 1) << 5); R = (st >> 1) * 16 + swz / 64; C = (st & 1) * 32 + (swz % 64) / 2; }
__host__ __device__ __forceinline__ int perm32(int rho) { const int n = rho >> 4, i = rho & 15; return 8 * (i >> 2) + 4 * n + (i & 3); }

struct Unit { int pm, pn; };
struct Gemm { const bf16_t* A; const bf16_t* Bt; int M, N, K; };

struct StaticOrder {
    int nM, nN, nwg, G, c;
    __host__ __device__ void init(int M, int N, int G_, int c_) { nM = M / BM; nN = N / BM; nwg = nM * nN; G = G_; c = c_; }
    __host__ __device__ bool next(int i, Unit& u) const {
        const long L = (long)i * G + c; if (L >= nwg) return false;
        int wgid = (int)L; { const int q = nwg / NXCD, r = nwg % NXCD, xcd = wgid % NXCD, off = wgid / NXCD; wgid = (xcd < r ? xcd * (q + 1) : r * (q + 1) + (xcd - r) * q) + off; }
        const int nig = WGM * nN, gid = wgid / nig, fm = gid * WGM, gsz = (nM - fm) < WGM ? (nM - fm) : WGM;
        u.pm = fm + ((wgid % nig) % gsz); u.pn = (wgid % nig) / gsz; return true;
    }
    __device__ __forceinline__ void a_ready(const Unit&) const {}
    __device__ __forceinline__ void done(const Unit&) const {}
};

__device__ __forceinline__ unsigned cvt_pk_bf16(float lo, float hi) { unsigned r; asm volatile("v_cvt_pk_bf16_f32 %0, %1, %2" : "=v"(r) : "v"(lo), "v"(hi)); return r; }
typedef float f32x2 __attribute__((ext_vector_type(2)));
typedef float f32x2 __attribute__((ext_vector_type(2)));
typedef __bf16 bf16x2_t __attribute__((ext_vector_type(2)));
__device__ __forceinline__ unsigned cvtpk(float lo, float hi) { f32x2 v = {lo, hi}; bf16x2_t b = __builtin_convertvector(v, bf16x2_t); return __builtin_bit_cast(unsigned, b); }
__device__ __forceinline__ bf16_t cvt1(float v) { return (bf16_t)(cvtpk(v, 0.f) & 0xffffu); }

struct EpiProj {
    static constexpr bool PERM = true, AFTER_DRAIN = false;
    bf16_t* QK; bf16_t* VT; const float* rope;
    __device__ __forceinline__ void operator()(const f32x4 (&acc)[2][2][4][2], const Unit& u, int wr, int wc, int fr, int fq) const {
        const int pn = u.pn;
        const int row0 = u.pm * BM + wr * 64 + fr;
        const int cin = wc * 32 + 8 * fq;
        if (pn == 4 || pn == 5 || pn == 8 || pn == 11) {
            const size_t voff = (pn <= 5) ? (size_t)0 : (pn == 8 ? VTB_OFF : VTC_OFF);
            bf16_t* base = VT + voff;
            const int nd = (pn <= 5) ? 128 : 64, c0 = (pn == 5) ? 256 : 0;
#pragma unroll
            for (int ai = 0; ai < 2; ++ai)
#pragma unroll
                for (int m = 0; m < 4; ++m) {
                    const int row = row0 + ai * HALF + m * 16, b = row >> 12, s = row & (SEQ - 1);
#pragma unroll
                    for (int bj = 0; bj < 2; ++bj) {
                        const int c = c0 + bj * HALF + cin;
                        const int h = c / nd, e = c % nd;
                        bf16_t* p = base + ((size_t)((b * 4 + h) * nd + e)) * SEQ + s;
#pragma unroll
                        for (int n = 0; n < 2; ++n)
#pragma unroll
                            for (int i = 0; i < 4; ++i) p[(size_t)(4 * n + i) * SEQ] = cvt1(acc[ai][bj][m][n][i]);
                    }
                }
            return;
        }
        int dcol; bool rope_on = false; float sc = 1.f;
        if (pn <= 1) { dcol = pn * 256; rope_on = true; sc = QSCALE; }
        else if (pn <= 3) { dcol = 512 + (pn - 2) * 256; rope_on = true; }
        else if (pn == 6) { dcol = 1024; sc = QSCALE; }
        else if (pn == 7) { dcol = 1280; }
        else if (pn == 9) { dcol = 1536; sc = QSCALE; }
        else { dcol = 1792; }
        const bool rl = ((wc & 1) == 0) && (fq < 2);
#pragma unroll
        for (int ai = 0; ai < 2; ++ai)
#pragma unroll
            for (int m = 0; m < 4; ++m) {
                const int row = row0 + ai * HALF + m * 16;
#pragma unroll
                for (int bj = 0; bj < 2; ++bj) {
                    f32x4 v0 = acc[ai][bj][m][0], v1 = acc[ai][bj][m][1];
                    if (rope_on) {
                        f32x4 o0, o1;
#pragma unroll
                        for (int i = 0; i < 4; ++i) { o0[i] = __shfl_xor(v0[i], 16); o1[i] = __shfl_xor(v1[i], 16); }
                        if (rl) {
                            const f32x4* t = (const f32x4*)(rope + (size_t)(row & (SEQ - 1)) * 16);
                            const f32x4 c0 = t[0], c1 = t[1], s0 = t[2], s1 = t[3];
                            if (fq == 0) { v0 = v0 * c0 - o0 * s0; v1 = v1 * c1 - o1 * s1; }
                            else         { v0 = v0 * c0 + o0 * s0; v1 = v1 * c1 + o1 * s1; }
                        }
                    }
                    v0 = v0 * sc; v1 = v1 * sc;
                    u32x4 w; w.x = cvtpk(v0[0], v0[1]); w.y = cvtpk(v0[2], v0[3]); w.z = cvtpk(v1[0], v1[1]); w.w = cvtpk(v1[2], v1[3]);
                    *(u32x4*)(QK + (size_t)row * QKP + dcol + bj * HALF + cin) = w;
                }
            }
    }
};
struct EpiY {
    static constexpr bool PERM = true, AFTER_DRAIN = false;
    bf16_t* O; int ldc;
    __device__ __forceinline__ void operator()(const f32x4 (&acc)[2][2][4][2], const Unit& u, int wr, int wc, int fr, int fq) const {
        const int row0 = u.pm * BM + wr * 64 + fr, col0 = u.pn * BM + wc * 32 + 8 * fq;
#pragma unroll
        for (int ai = 0; ai < 2; ++ai)
#pragma unroll
            for (int m = 0; m < 4; ++m) { bf16_t* rowp = O + (size_t)(row0 + ai * HALF + m * 16) * ldc + col0;
#pragma unroll
                for (int bj = 0; bj < 2; ++bj) { const f32x4 v0 = acc[ai][bj][m][0], v1 = acc[ai][bj][m][1];
                    u32x4 w; w.x = cvtpk(v0[0], v0[1]); w.y = cvtpk(v0[2], v0[3]); w.z = cvtpk(v1[0], v1[1]); w.w = cvtpk(v1[2], v1[3]);
                    *(u32x4*)(rowp + bj * HALF) = w; } }
    }
};
struct EpiRelu2 {
    static constexpr bool PERM = true, AFTER_DRAIN = false;
    bf16_t* O; int ldc;
    __device__ __forceinline__ void operator()(const f32x4 (&acc)[2][2][4][2], const Unit& u, int wr, int wc, int fr, int fq) const {
        const int row0 = u.pm * BM + wr * 64 + fr, col0 = u.pn * BM + wc * 32 + 8 * fq;
#pragma unroll
        for (int ai = 0; ai < 2; ++ai)
#pragma unroll
            for (int m = 0; m < 4; ++m) { bf16_t* rowp = O + (size_t)(row0 + ai * HALF + m * 16) * ldc + col0;
#pragma unroll
                for (int bj = 0; bj < 2; ++bj) { f32x4 v0 = acc[ai][bj][m][0], v1 = acc[ai][bj][m][1];
#pragma unroll
                    for (int i = 0; i < 4; ++i) { const float a = fmaxf(v0[i], 0.f), b = fmaxf(v1[i], 0.f); v0[i] = a * a; v1[i] = b * b; }
                    u32x4 w; w.x = cvtpk(v0[0], v0[1]); w.y = cvtpk(v0[2], v0[3]); w.z = cvtpk(v1[0], v1[1]); w.w = cvtpk(v1[2], v1[3]);
                    *(u32x4*)(rowp + bj * HALF) = w; } }
    }
};

template <class Epi, class Sched, bool ALIGN_EPI = false, bool SP2 = false>
__device__ __forceinline__ void gemm_phase(PG8_LAS unsigned char* lds, const Gemm g, const Sched& S, const Epi& E) {
    const int tid = fresh_tid(), wid = __builtin_amdgcn_readfirstlane(tid >> 6), lane = tid & 63, wr = wid >> 2, wc = wid & 3, fr = lane & 15, fq = lane >> 4;
    const int K = g.K, nt = K / BK;
    unsigned voffA[2], voffB[2];
#pragma unroll
    for (int i = 0; i < 2; ++i) { int R, C; stage_rc(tid * 16 + i * 8192, R, C); const int Rb = Epi::PERM ? ((R & ~31) + perm32(R & 31)) : R;
        voffA[i] = (unsigned)(R * K + C) * 2u; voffB[i] = (unsigned)(Rb * K + C) * 2u; }
    const size_t kstep = (size_t)(BK * 2);
    const size_t hstep = (size_t)HALF * K * 2;
    const size_t tstep = 2 * hstep;
    const unsigned ldsw = (unsigned)wid * 1024u;
    const int aoff = lds_byte(wr * 64 + fr, fq * 8), boff = lds_byte(wc * 32 + fr, fq * 8);
#define PG8_SA(b, h) (((b) * 2 + (h)) * HTB)
#define PG8_SB(b, h) ((4 + (b) * 2 + (h)) * HTB)
#define PG8_STAGE(bufoff, gbase, voff) do { _Pragma("unroll") for (int _i = 0; _i < 2; ++_i) \
        __builtin_amdgcn_global_load_lds((const unsigned*)((const char*)(gbase) + (voff)[_i]), (PG8_LAS unsigned*)(lds + (bufoff) + ldsw + _i * 8192), 16, 0, 0); } while (0)
#define PG8_LDA(dst, b, h) do { _Pragma("unroll") for (int m = 0; m < 4; ++m) _Pragma("unroll") for (int k = 0; k < 2; ++k) dst[m][k] = *(const PG8_LAS bf16x8*)(lds + PG8_SA(b, h) + aoff + m * 2048 + k * 1024); } while (0)
#define PG8_LDB(dst, b, h) do { _Pragma("unroll") for (int n = 0; n < 2; ++n) _Pragma("unroll") for (int k = 0; k < 2; ++k) dst[n][k] = *(const PG8_LAS bf16x8*)(lds + PG8_SB(b, h) + boff + n * 2048 + k * 1024); } while (0)
#define PG8_MMA(ai, bj, At, Bt) do { __builtin_amdgcn_s_setprio(1); _Pragma("unroll") for (int m = 0; m < 4; ++m) _Pragma("unroll") for (int n = 0; n < 2; ++n) _Pragma("unroll") for (int k = 0; k < 2; ++k) \
        acc[ai][bj][m][n] = __builtin_amdgcn_mfma_f32_16x16x32_bf16(Bt[n][k], At[m][k], acc[ai][bj][m][n], 0, 0, 0); __builtin_amdgcn_s_setprio(0); } while (0)
#define PG8_WAIT_V(n) asm volatile("s_waitcnt vmcnt(" #n ")" ::: "memory")
#define PG8_WAIT_L(n) asm volatile("s_waitcnt lgkmcnt(" #n ")" ::: "memory")
#define PG8_BAR __builtin_amdgcn_s_barrier()
#define PG8_SCHED __builtin_amdgcn_sched_barrier(0)
    Unit cur, nxt; int ui = 0;
    if (!S.next(0, cur)) return;
    f32x4 acc[2][2][4][2];
#pragma unroll
    for (int a = 0; a < 2; ++a)
#pragma unroll
        for (int b = 0; b < 2; ++b)
#pragma unroll
            for (int m = 0; m < 4; ++m)
#pragma unroll
                for (int n = 0; n < 2; ++n) acc[a][b][m][n] = (f32x4){0.f, 0.f, 0.f, 0.f};
    bf16x8 At[4][2], B0[2][2], B1[2][2];
    const char* cA = (const char*)g.A + (size_t)cur.pm * tstep; const char* cB = (const char*)g.Bt + (size_t)cur.pn * tstep;
    S.a_ready(cur);
    if constexpr (SP2) {
        PG8_STAGE(PG8_SB(0, 0), cB, voffB); PG8_STAGE(PG8_SB(0, 1), cB + hstep, voffB); PG8_STAGE(PG8_SA(0, 0), cA, voffA); PG8_STAGE(PG8_SA(0, 1), cA + hstep, voffA);
        if (wr == 1) PG8_BAR;
        PG8_WAIT_V(2); PG8_BAR;
        PG8_STAGE(PG8_SB(1, 0), cB + kstep, voffB); PG8_STAGE(PG8_SA(1, 0), cA + kstep, voffA); PG8_STAGE(PG8_SB(1, 1), cB + hstep + kstep, voffB);
        PG8_WAIT_V(6); PG8_BAR;
    } else {
        PG8_STAGE(PG8_SB(0, 0), cB, voffB); PG8_STAGE(PG8_SA(0, 0), cA, voffA); PG8_STAGE(PG8_SB(0, 1), cB + hstep, voffB); PG8_STAGE(PG8_SA(0, 1), cA + hstep, voffA);
        if (wr == 1) PG8_BAR;
        PG8_WAIT_V(4); PG8_BAR;
        PG8_STAGE(PG8_SB(1, 0), cB + kstep, voffB); PG8_STAGE(PG8_SA(1, 0), cA + kstep, voffA); PG8_STAGE(PG8_SB(1, 1), cB + hstep + kstep, voffB);
        PG8_WAIT_V(6); PG8_BAR;
    }
    for (;;) {
        const bool has_next = S.next(ui + 1, nxt);
        const char* nA = has_next ? (const char*)g.A + (size_t)nxt.pm * tstep : cA; const char* nB = has_next ? (const char*)g.Bt + (size_t)nxt.pn * tstep : cB;
        for (int t = 0; t < nt; t += 2) {
            const bool last = (t == nt - 2);
            const char* a1 = cA + (size_t)(t + 1) * kstep;
            const char* a2 = last ? nA : cA + (size_t)(t + 2) * kstep; const char* b2 = last ? nB : cB + (size_t)(t + 2) * kstep;
            const char* a3 = a2 + kstep; const char* b3 = b2 + kstep;
            if (last && has_next) S.a_ready(nxt);
            if constexpr (SP2) {
            PG8_LDB(B0, 0, 0); PG8_LDB(B1, 0, 1); PG8_SCHED; PG8_LDA(At, 0, 0); PG8_STAGE(PG8_SA(1, 1), a1 + hstep, voffA);
            PG8_WAIT_V(8); PG8_WAIT_L(0); PG8_BAR; PG8_MMA(0, 0, At, B0); PG8_MMA(0, 1, At, B1); PG8_BAR; PG8_SCHED;
            PG8_LDA(At, 0, 1); PG8_STAGE(PG8_SB(0, 0), b2, voffB); PG8_STAGE(PG8_SB(0, 1), b2 + hstep, voffB); PG8_STAGE(PG8_SA(0, 0), a2, voffA);
            PG8_WAIT_V(8); PG8_WAIT_L(0); PG8_BAR; PG8_MMA(1, 0, At, B0); PG8_MMA(1, 1, At, B1); PG8_BAR; PG8_SCHED;
            PG8_LDB(B0, 1, 0); PG8_LDB(B1, 1, 1); PG8_SCHED; PG8_LDA(At, 1, 0); PG8_STAGE(PG8_SA(0, 1), a2 + hstep, voffA);
            PG8_WAIT_V(8); PG8_WAIT_L(0); PG8_BAR; PG8_MMA(0, 0, At, B0); PG8_MMA(0, 1, At, B1); PG8_BAR; PG8_SCHED;
            PG8_LDA(At, 1, 1); PG8_STAGE(PG8_SB(1, 0), b3, voffB); PG8_STAGE(PG8_SB(1, 1), b3 + hstep, voffB); PG8_STAGE(PG8_SA(1, 0), a3, voffA);
            PG8_WAIT_V(8); PG8_WAIT_L(0); PG8_BAR; PG8_MMA(1, 0, At, B0); PG8_MMA(1, 1, At, B1); PG8_BAR; PG8_SCHED;
            } else {
            PG8_LDB(B0, 0, 0); PG8_SCHED; PG8_LDA(At, 0, 0); PG8_STAGE(PG8_SA(1, 1), a1 + hstep, voffA);
            PG8_WAIT_L(8); PG8_BAR; PG8_WAIT_L(0); PG8_MMA(0, 0, At, B0); PG8_BAR; PG8_SCHED;
            PG8_LDB(B1, 0, 1); PG8_STAGE(PG8_SB(0, 0), b2, voffB);
            PG8_BAR; PG8_WAIT_L(0); PG8_MMA(0, 1, At, B1); PG8_BAR;
            PG8_LDA(At, 0, 1); PG8_STAGE(PG8_SA(0, 0), a2, voffA);
            PG8_BAR; PG8_WAIT_L(0); PG8_MMA(1, 0, At, B0); PG8_BAR; PG8_SCHED;
            PG8_STAGE(PG8_SB(0, 1), b2 + hstep, voffB);
            PG8_WAIT_V(6); PG8_BAR; PG8_MMA(1, 1, At, B1); PG8_BAR;
            PG8_LDB(B0, 1, 0); PG8_SCHED; PG8_LDA(At, 1, 0); PG8_STAGE(PG8_SA(0, 1), a2 + hstep, voffA);
            PG8_WAIT_L(8); PG8_BAR; PG8_WAIT_L(0); PG8_MMA(0, 0, At, B0); PG8_BAR; PG8_SCHED;
            PG8_LDB(B1, 1, 1); PG8_STAGE(PG8_SB(1, 0), b3, voffB);
            PG8_BAR; PG8_WAIT_L(0); PG8_MMA(0, 1, At, B1); PG8_BAR;
            PG8_LDA(At, 1, 1); PG8_STAGE(PG8_SA(1, 0), a3, voffA);
            PG8_BAR; PG8_WAIT_L(0); PG8_MMA(1, 0, At, B0); PG8_BAR; PG8_SCHED;
            PG8_STAGE(PG8_SB(1, 1), b3 + hstep, voffB);
            PG8_WAIT_V(6); PG8_BAR; PG8_MMA(1, 1, At, B1); PG8_BAR;
            }
        }
        if constexpr (ALIGN_EPI) { if (wr == 0) PG8_BAR; }
        if constexpr (!Epi::AFTER_DRAIN) { E(acc, cur, wr, wc, fr, fq); S.done(cur); }
        if (!has_next) break;
#pragma unroll
        for (int a = 0; a < 2; ++a)
#pragma unroll
            for (int b = 0; b < 2; ++b)
#pragma unroll
                for (int m = 0; m < 4; ++m)
#pragma unroll
                    for (int n = 0; n < 2; ++n) acc[a][b][m][n] = (f32x4){0.f, 0.f, 0.f, 0.f};
        cur = nxt; cA = nA; cB = nB; ++ui;
        if constexpr (ALIGN_EPI) { if (wr == 1) PG8_BAR; }
    }
    PG8_WAIT_V(0);
    if constexpr (!ALIGN_EPI) { if (wr == 0) PG8_BAR; }
    PG8_BAR;
    if constexpr (Epi::AFTER_DRAIN) { E.fused(acc, cur, wr, wc, fr, fq, lds, wid, lane); S.done(cur); }
#undef PG8_SA
#undef PG8_SB
#undef PG8_STAGE
#undef PG8_LDA
#undef PG8_LDB
#undef PG8_MMA
#undef PG8_WAIT_V
#undef PG8_WAIT_L
#undef PG8_BAR
#undef PG8_SCHED
}
}
#define XB_TMO      128
#define XB_XCNT(j)  (256  + 64 * (j))
#define XB_XSUB(j)  (1280 + 64 * (j))
#define XB_XGEN(j)  (2304 + 64 * (j))
#define XB_TOP      3328
#define XB_TOPGEN   3392
#define XCD_BAR_WORDS 3456
#define XB_SPIN_CAP (1u << 18)

__device__ __forceinline__ unsigned xb_ld(unsigned* p)              { return __hip_atomic_load(p, __ATOMIC_RELAXED, __HIP_MEMORY_SCOPE_AGENT); }
__device__ __forceinline__ unsigned xb_add(unsigned* p, unsigned v) { return __hip_atomic_fetch_add(p, v, __ATOMIC_RELAXED, __HIP_MEMORY_SCOPE_AGENT); }
__device__ __forceinline__ unsigned xb_xcc_id() { return (unsigned)__builtin_amdgcn_s_getreg((3 << 11) | 20) & 0xFu; }
#define XB_SPIN(cond, bar) do { unsigned _sp = 0; while (cond) { __builtin_amdgcn_s_sleep(1); \
    if ((++_sp & 255u) == 0u) { if (xb_ld(&(bar)[XB_TMO])) break; if (_sp > XB_SPIN_CAP) { atomicAdd(&(bar)[XB_TMO], 1u); break; } } } } while (0)

struct XcdBarrier {
    unsigned* bar; unsigned x;
    volatile LAS unsigned* st;
};

__device__ __forceinline__ XcdBarrier xcd_barrier_post(unsigned* bar, volatile LAS unsigned* st) {
    XcdBarrier b; b.bar = bar; b.x = xb_xcc_id(); b.st = st;
    if (threadIdx.x == 0) (void)xb_add(&bar[XB_XCNT(b.x)], 1u);
    return b;
}
__device__ __forceinline__ void xcd_barrier_complete(unsigned* bar, unsigned x, unsigned& nloc, unsigned& nx) {
    const unsigned G = gridDim.x * gridDim.y * gridDim.z;
    unsigned sum, cnt, mine, sp = 0u;
    for (;;) {
        sum = 0u; cnt = 0u; mine = 0u;
#pragma unroll
        for (unsigned j = 0; j < 16; ++j) { const unsigned c = xb_ld(&bar[XB_XCNT(j)]); sum += c; cnt += (c > 0u) ? 1u : 0u; mine = (j == x) ? c : mine; }
        if (sum == G) break;
        __builtin_amdgcn_s_sleep(1);
        if ((++sp & 255u) == 0u) { if (xb_ld(&bar[XB_TMO])) break; if (sp > XB_SPIN_CAP) { atomicAdd(&bar[XB_TMO], 1u); break; } }
    }
    nloc = mine > 0u ? mine : 1u; nx = cnt > 0u ? cnt : 1u;
}

__device__ __forceinline__ void xcd_barrier(const XcdBarrier& b) {
    asm volatile("s_waitcnt vmcnt(0)" ::: "memory");
    __syncthreads();
    if (threadIdx.x == 0) {
        unsigned* bar = b.bar;
        __builtin_amdgcn_s_waitcnt(0);
        unsigned nloc = b.st[0], nx = b.st[1];
        if (nloc == 0u) { xcd_barrier_complete(bar, b.x, nloc, nx); b.st[0] = nloc; b.st[1] = nx; }
        const unsigned old = xb_add(&bar[XB_XSUB(b.x)], 1u);
        const unsigned gen = old / nloc;
        if (old + 1u == (gen + 1u) * nloc) {
            __builtin_amdgcn_fence(__ATOMIC_RELEASE, "agent");
            asm volatile("s_waitcnt vmcnt(0)" ::: "memory");
            const unsigned og = xb_add(&bar[XB_TOP], 1u);
            const unsigned tg = og / nx;
            if (og + 1u == (tg + 1u) * nx) xb_add(&bar[XB_TOPGEN], 1u);
            else XB_SPIN(xb_ld(&bar[XB_TOPGEN]) == tg, bar);
            __builtin_amdgcn_fence(__ATOMIC_ACQUIRE, "agent");
            xb_add(&bar[XB_XGEN(b.x)], 1u);
            asm volatile("s_waitcnt vmcnt(0)" ::: "memory");
        } else {
            XB_SPIN(xb_ld(&bar[XB_XGEN(b.x)]) == gen, bar);
            __builtin_amdgcn_fence(__ATOMIC_ACQUIRE, "agent");
            asm volatile("s_waitcnt vmcnt(0)" ::: "memory");
        }
    }
    __syncthreads();
}

typedef unsigned short bf16_t;
typedef short bf16x8 __attribute__((ext_vector_type(8)));
typedef float f32x4 __attribute__((ext_vector_type(4)));
typedef float f32x16 __attribute__((ext_vector_type(16)));
typedef unsigned u32x4 __attribute__((ext_vector_type(4)));
typedef unsigned u32x2 __attribute__((ext_vector_type(2)));
using pg8::cvtpk;
#define MFMA32(a, b, c) __builtin_amdgcn_mfma_f32_32x32x16_bf16((a), (b), (c), 0, 0, 0)
__device__ __forceinline__ float wave_sum(float v) {
#pragma unroll
    for (int o = 1; o < 64; o <<= 1) v += __shfl_xor(v, o);
    return v;
}
__device__ __forceinline__ float ex2(float x) { return __builtin_amdgcn_exp2f(x); }
__device__ __forceinline__ float lg2(float x) { return __builtin_amdgcn_logf(x); }

constexpr size_t MiB = 1u << 20;
constexpr size_t WS_ROPE = 1 * MiB;
constexpr size_t WS_WI = 2 * MiB, WS_WO = 8 * MiB, WS_WU = 10 * MiB, WS_WD = 18 * MiB;
constexpr size_t WS_HN = 26 * MiB;
constexpr size_t WS_Y = 58 * MiB;
constexpr size_t WS_QK = 58 * MiB;
constexpr size_t WS_U = 122 * MiB;
constexpr size_t WS_VTA = 122 * MiB, WS_VTB = 138 * MiB, WS_VTC = 146 * MiB;
constexpr size_t WS_OA = 154 * MiB;
constexpr size_t WS_CAT = 218 * MiB;
constexpr size_t WS_END = 250 * MiB;
static_assert(WS_VTB - WS_VTA == VTB_OFF * 2 && WS_VTC - WS_VTA == VTC_OFF * 2, "V^T offsets");

namespace att {
constexpr int KROW = 144;
constexpr int KBUF = 64 * KROW, VBUF = 128 * KROW;
constexpr int L_K0 = 0, L_K1 = KBUF, L_V0 = 2 * KBUF, L_V1 = 2 * KBUF + VBUF, L_MISC = 2 * KBUF + 2 * VBUF;
constexpr int L_RB = L_MISC, L_FLAG = L_MISC + 2048;

template <int DV> struct TileRegs { u32x4 k; u32x4 v[DV / 64]; };
template <int DV> __device__ __forceinline__ void tile_load(TileRegs<DV>& r, const bf16_t* Kb, const bf16_t* Vb, int key0, int tid) {
    const int row = tid >> 3, ch = tid & 7;
    r.k = *(const u32x4*)(Kb + (size_t)(key0 + row) * QKP + ch * 8);
#pragma unroll
    for (int i = 0; i < DV / 64; ++i) r.v[i] = *(const u32x4*)(Vb + (size_t)(row + 64 * i) * SEQ + key0 + ch * 8);
}
template <int DV> __device__ __forceinline__ void tile_store(const TileRegs<DV>& r, LAS unsigned char* lds, int kbuf, int vbuf, int tid) {
    const int row = tid >> 3, ch = tid & 7;
    *(LAS u32x4*)(lds + kbuf + row * KROW + ch * 16) = r.k;
#pragma unroll
    for (int i = 0; i < DV / 64; ++i) *(LAS u32x4*)(lds + vbuf + (row + 64 * i) * KROW + ch * 16) = r.v[i];
}
__device__ __forceinline__ void qk_tile(f32x16& s0, f32x16& s1, LAS const unsigned char* kp, const bf16x8 (&q)[4]) {
#pragma unroll
    for (int i = 0; i < 16; ++i) { s0[i] = 0.f; s1[i] = 0.f; }
#pragma unroll
    for (int d0 = 0; d0 < 4; ++d0) {
        const bf16x8 a0 = *(LAS const bf16x8*)(kp + d0 * 32), a1 = *(LAS const bf16x8*)(kp + 32 * KROW + d0 * 32);
        s0 = MFMA32(a0, q[d0], s0); s1 = MFMA32(a1, q[d0], s1);
    }
}
__device__ __forceinline__ bf16x8 pack8(const f32x16& s, int b) {
    u32x4 w; w.x = cvtpk(s[b], s[b + 1]); w.y = cvtpk(s[b + 2], s[b + 3]); w.z = cvtpk(s[b + 4], s[b + 5]); w.w = cvtpk(s[b + 6], s[b + 7]);
    return __builtin_bit_cast(bf16x8, w);
}
template <int NDB> __device__ __forceinline__ void pv_tile(f32x16 (&o)[NDB], LAS const unsigned char* vp, const bf16x8 (&pf)[4]) {
#pragma unroll
    for (int db = 0; db < NDB; ++db)
#pragma unroll
        for (int kg = 0; kg < 4; ++kg) { const bf16x8 a = *(LAS const bf16x8*)(vp + db * 32 * KROW + kg * 32); o[db] = MFMA32(a, pf[kg], o[db]); }
}
template <int NDB> __device__ __forceinline__ void softmax_update(f32x16& s0, f32x16& s1, float& m, float& l, f32x16 (&o)[NDB], LAS const unsigned char* vp) {
    float mx = fmaxf(s0[0], s1[0]);
#pragma unroll
    for (int i = 1; i < 16; ++i) mx = fmaxf(mx, fmaxf(s0[i], s1[i]));
    mx = fmaxf(mx, __shfl_xor(mx, 32));
    const float mn = fmaxf(m, mx), alpha = ex2(m - mn); m = mn;
    float ps = 0.f;
#pragma unroll
    for (int i = 0; i < 16; ++i) { s0[i] = ex2(s0[i] - mn); s1[i] = ex2(s1[i] - mn); ps += s0[i] + s1[i]; }
    l = l * alpha + ps;
#pragma unroll
    for (int db = 0; db < NDB; ++db) o[db] = o[db] * alpha;
    bf16x8 pf[4]; pf[0] = pack8(s0, 0); pf[1] = pack8(s0, 8); pf[2] = pack8(s1, 0); pf[3] = pack8(s1, 8);
    pv_tile<NDB>(o, vp, pf);
}
struct Lane { int tid, wid, lane, rho, hi, koff, voff; };
__device__ __forceinline__ Lane make_lane() {
    Lane L; L.tid = fresh_tid(); L.wid = __builtin_amdgcn_readfirstlane(L.tid >> 6); L.lane = L.tid & 63; L.rho = L.lane & 31; L.hi = L.lane >> 5;
    const int pr = (L.rho & ~12) | ((L.rho & 4) << 1) | ((L.rho & 8) >> 1);
    L.koff = pr * KROW + L.hi * 16; L.voff = L.rho * KROW + L.hi * 16; return L;
}
__device__ __forceinline__ void load_q(bf16x8 (&q)[4], const bf16_t* Qrow  ) {
#pragma unroll
    for (int d0 = 0; d0 < 4; ++d0) q[d0] = *(const bf16x8*)(Qrow + d0 * 16);
}

constexpr int STG_A = KBUF + VBUF;
__device__ __forceinline__ void qk_tile_ref(f32x16& s0, f32x16& s1, LAS const unsigned char* kp, const bf16x8 (&q)[4], float negm) {
#pragma unroll
    for (int i = 0; i < 16; ++i) { s0[i] = negm; s1[i] = negm; }
#pragma unroll
    for (int d0 = 0; d0 < 4; ++d0) {
        const bf16x8 a0 = *(LAS const bf16x8*)(kp + d0 * 32), a1 = *(LAS const bf16x8*)(kp + 32 * KROW + d0 * 32);
        s0 = MFMA32(a0, q[d0], s0); s1 = MFMA32(a1, q[d0], s1);
    }
}
template <int NDB, bool HAS_NEXT> __device__ __forceinline__ void sm_tile(f32x16& s0, f32x16& s1, f32x16& n0, f32x16& n1, bool first, float& m, float& l, f32x16 (&o)[NDB], LAS const unsigned char* vp) {
    float mx = fmaxf(s0[0], s1[0]);
#pragma unroll
    for (int i = 1; i < 16; ++i) mx = fmaxf(mx, fmaxf(s0[i], s1[i]));
    mx = fmaxf(mx, __shfl_xor(mx, 32));
    if (first || __any(mx > 8.0f)) {
        const float dl = first ? mx : fmaxf(mx, 0.f);
        m += dl; s0 = s0 - dl; s1 = s1 - dl;
        if (HAS_NEXT) { n0 = n0 - dl; n1 = n1 - dl; }
        if (!first) { const float alpha = ex2(-dl); l *= alpha;
#pragma unroll
            for (int db = 0; db < NDB; ++db) o[db] = o[db] * alpha; }
    }
    float ps = 0.f;
#pragma unroll
    for (int i = 0; i < 16; ++i) { s0[i] = ex2(s0[i]); s1[i] = ex2(s1[i]); }
#pragma unroll
    for (int i = 0; i < 16; ++i) ps += s0[i] + s1[i];
    l += ps;
    bf16x8 pf[4]; pf[0] = pack8(s0, 0); pf[1] = pack8(s0, 8); pf[2] = pack8(s1, 0); pf[3] = pack8(s1, 8);
    pv_tile<NDB>(o, vp, pf);
}
__device__ __forceinline__ void attnA_item(LAS unsigned char* lds, const Lane& L, const bf16_t* QK, const bf16_t* VTa, float* OA, int b, int h, int n, int qblk) {
    const int rowq = qblk * 256 + L.wid * 32, cw = rowq >> 6;
    const size_t tok0 = (size_t)b * SEQ;
    bf16x8 q[4]; load_q(q, QK + (tok0 + rowq + L.rho) * QKP + h * 128 + n * 64 + L.hi * 8);
    const bf16_t* Kb = QK + tok0 * QKP + 512 + h * 128 + n * 64;
    const bf16_t* Vb = VTa + (size_t)((b * 4 + h) * 128) * SEQ;
    const int NT = 4 * qblk + 4;
    TileRegs<128> tr;
    tile_load<128>(tr, Kb, Vb, 0, L.tid); tile_store<128>(tr, lds, 0, KBUF, L.tid); __syncthreads();
    float m = 0.f, l = 0.f; f32x16 o[4];
#pragma unroll
    for (int db = 0; db < 4; ++db)
#pragma unroll
        for (int i = 0; i < 16; ++i) o[db][i] = 0.f;
    int sc = 0, sn = STG_A;
    for (int t = 0; t < NT; ++t) {
        if (t + 1 < NT) tile_load<128>(tr, Kb, Vb, (t + 1) * 64, L.tid);
        if (t <= cw) {
            f32x16 c0, c1; qk_tile_ref(c0, c1, lds + sc + L.koff, q, -m);
            sm_tile<4, false>(c0, c1, c0, c1, t == 0, m, l, o, lds + sc + KBUF + L.voff);
        }
        if (t + 1 < NT) tile_store<128>(tr, lds, sn, sn + KBUF, L.tid);
        __syncthreads();
        const int tmp = sc; sc = sn; sn = tmp;
    }
    l += __shfl_xor(l, 32);
    const float inv = 1.0f / l;
    float* op = OA + ((size_t)n * NTOK + tok0 + rowq + L.rho) * 512 + h * 128 + 4 * L.hi;
#pragma unroll
    for (int db = 0; db < 4; ++db)
#pragma unroll
        for (int g = 0; g < 4; ++g) { f32x4 v = {o[db][4 * g], o[db][4 * g + 1], o[db][4 * g + 2], o[db][4 * g + 3]}; *(f32x4*)(op + db * 32 + 8 * g) = v * inv; }
}
__device__ __forceinline__ void store_head_norm(const f32x16 (&o)[2], const Lane& L, const float* gain  , bf16_t* dst  ) {
    float ss = 0.f;
#pragma unroll
    for (int db = 0; db < 2; ++db)
#pragma unroll
        for (int i = 0; i < 16; ++i) ss += o[db][i] * o[db][i];
    ss += __shfl_xor(ss, 32);
    const float rs = rsqrtf(ss * (1.0f / 64.0f) + RMS_EPS);
#pragma unroll
    for (int db = 0; db < 2; ++db)
#pragma unroll
        for (int g = 0; g < 4; ++g) { const int d = db * 32 + 8 * g + 4 * L.hi; const f32x4 gv = *(const f32x4*)(gain + d);
            u32x2 w; w.x = cvtpk(o[db][4 * g] * rs * gv[0], o[db][4 * g + 1] * rs * gv[1]); w.y = cvtpk(o[db][4 * g + 2] * rs * gv[2], o[db][4 * g + 3] * rs * gv[3]);
            *(u32x2*)(dst + d) = w; }
}
__device__ __forceinline__ void attnB_item(LAS unsigned char* lds, const Lane& L, const bf16_t* QK, const bf16_t* VTb, bf16_t* CAT, const float* relb  , const float* gnb, int b, int h, int qblk) {
    const int rowq = qblk * 256 + L.wid * 32, cw = rowq >> 6;
    const size_t tok0 = (size_t)b * SEQ;
    LAS float* rb = (LAS float*)(lds + L_RB);
    if (L.tid < 257) rb[L.tid] = relb[h * 257 + L.tid] * LOG2E;
    bf16x8 q[4]; load_q(q, QK + (tok0 + rowq + L.rho) * QKP + 1024 + h * 64 + L.hi * 8);
    const bf16_t* Kb = QK + tok0 * QKP + 1280 + h * 64;
    const bf16_t* Vb = VTb + (size_t)((b * 4 + h) * 64) * SEQ;
    const int t_lo = (4 * qblk - 8) > 0 ? (4 * qblk - 8) : 0, t_hi = 4 * qblk + 3;
    TileRegs<64> tr;
    tile_load<64>(tr, Kb, Vb, t_lo * 64, L.tid); tile_store<64>(tr, lds, L_K0, L_V0, L.tid); __syncthreads();
    float m = -1e30f, l = 0.f; f32x16 o[2];
#pragma unroll
    for (int db = 0; db < 2; ++db)
#pragma unroll
        for (int i = 0; i < 16; ++i) o[db][i] = 0.f;
    const int qpos = rowq + L.rho;
    for (int t = t_lo; t <= t_hi; ++t) {
        const int cur = (t - t_lo) & 1;
        if (t < t_hi) tile_load<64>(tr, Kb, Vb, (t + 1) * 64, L.tid);
        if (t <= cw && t >= cw - 8) {
            f32x16 s0, s1; qk_tile(s0, s1, lds + (cur ? L_K1 : L_K0) + L.koff, q);
            if (cw - t >= 3) {
                const float bc = rb[256];
#pragma unroll
                for (int i = 0; i < 16; ++i) { s0[i] += bc; s1[i] += bc; }
            } else {
                const int rel0 = qpos - (t * 64 + 8 * L.hi);
#pragma unroll
                for (int r = 0; r < 16; ++r) { const int ko = 16 * (r >> 3) + (r & 7);
                    int i0 = rel0 - ko; i0 = (i0 > 128 ? 128 : i0) + 128; int i1 = rel0 - 32 - ko; i1 = (i1 > 128 ? 128 : i1) + 128;
                    s0[r] += rb[i0]; s1[r] += rb[i1]; }
            }
            softmax_update<2>(s0, s1, m, l, o, lds + (cur ? L_V1 : L_V0) + L.voff);
        }
        if (t < t_hi) tile_store<64>(tr, lds, cur ? L_K0 : L_K1, cur ? L_V0 : L_V1, L.tid);
        __syncthreads();
    }
    l += __shfl_xor(l, 32);
    const float inv = 1.0f / l;
#pragma unroll
    for (int db = 0; db < 2; ++db) o[db] = o[db] * inv;
    store_head_norm(o, L, gnb + h * 64, CAT + (tok0 + rowq + L.rho) * 1024 + 512 + h * 64);
}
__device__ __forceinline__ void stick_block(const f32x16& y, int kbase, int lim, int hi, float& R, bf16x8& pf0, bf16x8& pf1) {
    f32x16 ls, lb;
#pragma unroll
    for (int r = 0; r < 16; ++r) {
        const int kpos = kbase + 16 * (r >> 3) + 8 * hi + (r & 7);
        const float yy = y[r], sp = fmaxf(yy, 0.f) + lg2(1.0f + ex2(-fabsf(yy)));
        const bool valid = kpos < lim;
        ls[r] = valid ? -sp : 0.f;
        lb[r] = valid ? (yy - sp) : -1e30f;
    }
    float g0 = 0.f, g1 = 0.f;
#pragma unroll
    for (int i = 0; i < 8; ++i) { g0 += ls[i]; g1 += ls[8 + i]; }
    const float p0 = __shfl_xor(g0, 32), p1 = __shfl_xor(g1, 32);
    const float G11 = hi ? g1 : p1, G01 = hi ? p1 : g1, G10 = hi ? g0 : p0, G00 = hi ? p0 : g0;
    float run1 = R + (hi ? 0.f : G11);
    float run0 = R + (G11 + G01) + (hi ? 0.f : G10);
    f32x16 a;
#pragma unroll
    for (int i = 7; i >= 0; --i) {
        a[8 + i] = ex2(lb[8 + i] + run1); run1 += ls[8 + i];
        a[i] = ex2(lb[i] + run0); run0 += ls[i];
    }
    R += (G11 + G01) + (G10 + G00);
    pf0 = pack8(a, 0); pf1 = pack8(a, 8);
}
__device__ __forceinline__ void attnC_item(LAS unsigned char* lds, const Lane& L, const bf16_t* QK, const bf16_t* VTc, bf16_t* CAT, const float* gnc, int b, int h, int qblk) {
    const int rowq = qblk * 256 + L.wid * 32, cw = rowq >> 6;
    const size_t tok0 = (size_t)b * SEQ;
    volatile LAS unsigned* flag = (volatile LAS unsigned*)(lds + L_FLAG);
    bf16x8 q[4]; load_q(q, QK + (tok0 + rowq + L.rho) * QKP + 1536 + h * 64 + L.hi * 8);
    const bf16_t* Kb = QK + tok0 * QKP + 1792 + h * 64;
    const bf16_t* Vb = VTc + (size_t)((b * 4 + h) * 64) * SEQ;
    const int t_hi = 4 * qblk + 3;
    TileRegs<64> tr;
    tile_load<64>(tr, Kb, Vb, t_hi * 64, L.tid); tile_store<64>(tr, lds, L_K0, L_V0, L.tid); __syncthreads();
    float R = 0.f; f32x16 o[2];
#pragma unroll
    for (int db = 0; db < 2; ++db)
#pragma unroll
        for (int i = 0; i < 16; ++i) o[db][i] = 0.f;
    const int qpos = rowq + L.rho;
    bool wdone = false;
    for (int t = t_hi; t >= 0; --t) {
        const int it = t_hi - t, cur = it & 1;
        if (t > 0) tile_load<64>(tr, Kb, Vb, (t - 1) * 64, L.tid);
        if (t <= cw && !wdone) {
            f32x16 s0, s1; qk_tile(s0, s1, lds + (cur ? L_K1 : L_K0) + L.koff, q);
            const int lim = (t == cw) ? qpos : 0x7fffffff;
            bf16x8 pf[4];
            stick_block(s1, t * 64 + 32, lim, L.hi, R, pf[2], pf[3]);
            stick_block(s0, t * 64, lim, L.hi, R, pf[0], pf[1]);
            pv_tile<2>(o, lds + (cur ? L_V1 : L_V0) + L.voff, pf);
            wdone = __all(R < -150.0f) != 0;
        }
        if (L.lane == 0) flag[cur * 8 + L.wid] = (wdone || t == 0) ? 1u : 0u;
        if (t > 0) tile_store<64>(tr, lds, cur ? L_K0 : L_K1, cur ? L_V0 : L_V1, L.tid);
        __syncthreads();
        unsigned alld = 1u;
#pragma unroll
        for (int w = 0; w < 8; ++w) alld &= flag[cur * 8 + w];
        if (alld) break;
    }
    __syncthreads();
    store_head_norm(o, L, gnc + h * 64, CAT + (tok0 + rowq + L.rho) * 1024 + 768 + h * 64);
}
}

__device__ __forceinline__ void store_row_bf16(bf16_t* orow, const f32x4 (&v)[4], int lane) {
#pragma unroll
    for (int j = 0; j < 4; ++j) { u32x2 w; w.x = cvtpk(v[j][0], v[j][1]); w.y = cvtpk(v[j][2], v[j][3]); *((u32x2*)orow + lane + 64 * j) = w; }
}
__device__ __forceinline__ void prenorm_pass(const float* x, const float* g, bf16_t* HN, int gw, int NGW, int lane) {
    for (int m = gw; m < NTOK; m += NGW) {
        const f32x4* xr = (const f32x4*)(x + (size_t)m * DM) + lane; f32x4 v[4]; float s = 0.f;
#pragma unroll
        for (int j = 0; j < 4; ++j) { v[j] = xr[64 * j]; s += (v[j][0] * v[j][0] + v[j][1] * v[j][1]) + (v[j][2] * v[j][2] + v[j][3] * v[j][3]); }
        const float rs = rsqrtf(wave_sum(s) * (1.0f / DM) + RMS_EPS);
#pragma unroll
        for (int j = 0; j < 4; ++j) v[j] = v[j] * rs * ((const f32x4*)g)[lane + 64 * j];
        store_row_bf16(HN + (size_t)m * DM, v, lane);
    }
}
__device__ __forceinline__ void postnorm_pass(const bf16_t* Y, const float* xin, float* xout, const float* gpost, const float* gnext, bf16_t* HN, int gw, int NGW, int lane) {
    for (int m = gw; m < NTOK; m += NGW) {
        const u32x2* yr = (const u32x2*)(Y + (size_t)m * DM) + lane; const f32x4* xr = (const f32x4*)(xin + (size_t)m * DM) + lane;
        f32x4 y[4], v[4]; float s = 0.f;
#pragma unroll
        for (int j = 0; j < 4; ++j) { const u32x2 w = yr[64 * j]; v[j] = xr[64 * j];
            y[j][0] = __uint_as_float(w.x << 16); y[j][1] = __uint_as_float(w.x & 0xffff0000u); y[j][2] = __uint_as_float(w.y << 16); y[j][3] = __uint_as_float(w.y & 0xffff0000u);
            s += (y[j][0] * y[j][0] + y[j][1] * y[j][1]) + (y[j][2] * y[j][2] + y[j][3] * y[j][3]); }
        const float rs = rsqrtf(wave_sum(s) * (1.0f / DM) + RMS_EPS);
        float s2 = 0.f;
#pragma unroll
        for (int j = 0; j < 4; ++j) { v[j] = v[j] + y[j] * rs * ((const f32x4*)gpost)[lane + 64 * j]; s2 += (v[j][0] * v[j][0] + v[j][1] * v[j][1]) + (v[j][2] * v[j][2] + v[j][3] * v[j][3]); }
        f32x4* xo = (f32x4*)(xout + (size_t)m * DM) + lane;
#pragma unroll
        for (int j = 0; j < 4; ++j) xo[64 * j] = v[j];
        if (gnext) {
            const float rs2 = rsqrtf(wave_sum(s2) * (1.0f / DM) + RMS_EPS);
#pragma unroll
            for (int j = 0; j < 4; ++j) v[j] = v[j] * rs2 * ((const f32x4*)gnext)[lane + 64 * j];
            store_row_bf16(HN + (size_t)m * DM, v, lane);
        }
    }
}
__device__ __forceinline__ void combine_pass(const float* OA, bf16_t* CAT, const float* subln, float lam, float oscale, int gw, int NGW, int lane) {
    const int e0 = (lane & 15) * 8;
    const f32x4 g0 = *(const f32x4*)(subln + e0), g1 = *(const f32x4*)(subln + e0 + 4);
    for (int m = gw; m < NTOK; m += NGW) {
        const f32x4* a = (const f32x4*)(OA + (size_t)m * 512) + 2 * lane; const f32x4* c = (const f32x4*)(OA + ((size_t)NTOK + m) * 512) + 2 * lane;
        f32x4 d0 = a[0] - c[0] * lam, d1 = a[1] - c[1] * lam;
        float ss = (d0[0] * d0[0] + d0[1] * d0[1]) + (d0[2] * d0[2] + d0[3] * d0[3]) + (d1[0] * d1[0] + d1[1] * d1[1]) + (d1[2] * d1[2] + d1[3] * d1[3]);
#pragma unroll
        for (int o = 1; o < 16; o <<= 1) ss += __shfl_xor(ss, o);
        const float rs = rsqrtf(ss * (1.0f / 128.0f) + RMS_EPS) * oscale;
        d0 = d0 * rs * g0; d1 = d1 * rs * g1;
        u32x4 w; w.x = cvtpk(d0[0], d0[1]); w.y = cvtpk(d0[2], d0[3]); w.z = cvtpk(d1[0], d1[1]); w.w = cvtpk(d1[2], d1[3]);
        *((u32x4*)(CAT + (size_t)m * 1024) + lane) = w;
    }
}
__device__ __forceinline__ void transpose_item(const float* W, int K, int N, bf16_t* WT, LAS float* scr, int item, int lane) {
    const int nblk = N / 32, kb = item / nblk, nb = item % nblk, k0 = 64 * kb, n0 = 32 * nb;
#pragma unroll 8
    for (int i = 0; i < 32; ++i) { const int kk = 2 * i + (lane >> 5); scr[kk * 33 + (lane & 31)] = W[(size_t)(k0 + kk) * N + n0 + (lane & 31)]; }
    asm volatile("s_waitcnt lgkmcnt(0)" ::: "memory");
    const int c = lane & 7;
#pragma unroll
    for (int j = 0; j < 4; ++j) { const int n = (lane >> 3) + 8 * j; const LAS float* s = scr + (8 * c) * 33 + n;
        u32x4 o; o.x = cvtpk(s[0 * 33], s[1 * 33]); o.y = cvtpk(s[2 * 33], s[3 * 33]); o.z = cvtpk(s[4 * 33], s[5 * 33]); o.w = cvtpk(s[6 * 33], s[7 * 33]);
        *(u32x4*)(WT + (size_t)(n0 + n) * K + k0 + 8 * c) = o; }
    asm volatile("s_waitcnt lgkmcnt(0)" ::: "memory");
}

struct Args {
    const float* x; const float* g_pre_mix; const float* w_in; const float* lq1; const float* lk1; const float* lq2; const float* lk2;
    const float* subln; const float* relb; const float* gnb; const float* gnc; const float* w_out; const float* g_post_mix; const float* g_pre_mlp;
    const float* w_up; const float* w_down; const float* g_post_mlp;
    float* out; unsigned char* ws;
    float inv_freq[8]; float lam_init[2]; int ph_lo, ph_hi, coop, pad;
};
constexpr int NPHASE = 1 + 8 * NLAYER;
constexpr int LDS_BYTES = 147456;

__device__ __forceinline__ void convert_weights(const Args& a, int l, LAS unsigned char* lds, int gw, int NGW, int wave, int lane) {
    LAS float* scr = (LAS float*)(lds + wave * 16384);
    constexpr int I_IN = (DM / 64) * (DIN / 32), I_O = (DM / 64) * (DM / 32), I_U = (DM / 64) * (DFF / 32), I_D = (DFF / 64) * (DM / 32);
    constexpr int NITEMS = I_IN + I_O + I_U + I_D;
    bf16_t* Wi = (bf16_t*)(a.ws + WS_WI); bf16_t* Wo = (bf16_t*)(a.ws + WS_WO); bf16_t* Wu = (bf16_t*)(a.ws + WS_WU); bf16_t* Wd = (bf16_t*)(a.ws + WS_WD);
    for (int it = gw; it < NITEMS; it += NGW) {
        int r = it;
        if (r < I_IN) { transpose_item(a.w_in + (size_t)l * DM * DIN, DM, DIN, Wi, scr, r, lane); continue; } r -= I_IN;
        if (r < I_O) { transpose_item(a.w_out + (size_t)l * DM * DM, DM, DM, Wo, scr, r, lane); continue; } r -= I_O;
        if (r < I_U) { transpose_item(a.w_up + (size_t)l * DM * DFF, DM, DFF, Wu, scr, r, lane); continue; } r -= I_U;
        transpose_item(a.w_down + (size_t)l * DFF * DM, DFF, DM, Wd, scr, r, lane);
    }
}

__global__ void __launch_bounds__(512, 2) mk_fwd(Args a) {
    extern __shared__ __attribute__((aligned(16))) unsigned char lds_raw[];
    LAS unsigned char* lds = (LAS unsigned char*)lds_raw;
    cg::grid_group grid = cg::this_grid();
    const int G = gridDim.x, bx = blockIdx.x;
    const int vcu = (G % 8 == 0) ? (bx % 8) * (G / 8) + bx / 8 : bx;
    const int NGW = G * 8;
#define FRESH_IDS() const int tid = fresh_tid(), lane = tid & 63, wave = __builtin_amdgcn_readfirstlane(tid >> 6), gw = vcu * 8 + wave; (void)tid; (void)lane; (void)gw
    unsigned char* ws = a.ws;
    bf16_t* Wi = (bf16_t*)(ws + WS_WI); bf16_t* Wo = (bf16_t*)(ws + WS_WO); bf16_t* Wu = (bf16_t*)(ws + WS_WU); bf16_t* Wd = (bf16_t*)(ws + WS_WD);
    bf16_t* HN = (bf16_t*)(ws + WS_HN); bf16_t* Y = (bf16_t*)(ws + WS_Y); bf16_t* QK = (bf16_t*)(ws + WS_QK); bf16_t* U = (bf16_t*)(ws + WS_U);
    bf16_t* VTa = (bf16_t*)(ws + WS_VTA); bf16_t* VTb = (bf16_t*)(ws + WS_VTB); bf16_t* VTc = (bf16_t*)(ws + WS_VTC);
    float* OA = (float*)(ws + WS_OA); bf16_t* CAT = (bf16_t*)(ws + WS_CAT); float* rope = (float*)(ws + WS_ROPE);

    const int lo = a.ph_lo, hi = a.ph_hi;
    volatile LAS unsigned* bst = (volatile LAS unsigned*)(lds + LDS_BYTES - 64);
    if (threadIdx.x < 16) bst[threadIdx.x] = 0u;
    __syncthreads();
    XcdBarrier bar; bar.bar = (unsigned*)ws; bar.x = 0; bar.st = bst;
    if (a.coop) bar = xcd_barrier_post((unsigned*)ws, bst);
    if (a.pad == 0x7fffffff) grid.sync();
#define IN(p) (lo <= (p) && (p) < hi)
#define SEAM(p) do { if (IN((p) + 1) && a.coop) xcd_barrier(bar); } while (0)
    if (IN(0)) {
        FRESH_IDS();
        convert_weights(a, 0, lds, gw, NGW, wave, lane);
        for (int p = bx * 512 + tid; p < SEQ; p += G * 512) {
            f32x4 c[2], s[2];
#pragma unroll
            for (int j = 0; j < 8; ++j) {
                const float ang = (float)p * a.inv_freq[j];
                double t = (double)ang * 0.15915494309189535; t -= rint(t);
                const float tf = (float)t;
                c[j >> 2][j & 3] = __builtin_amdgcn_cosf(tf); s[j >> 2][j & 3] = __builtin_amdgcn_sinf(tf);
            }
            f32x4* o = (f32x4*)(rope + (size_t)p * 16); o[0] = c[0]; o[1] = c[1]; o[2] = s[0]; o[3] = s[1];
        }
        prenorm_pass(a.x, a.g_pre_mix, HN, gw, NGW, lane);
        SEAM(0);
    }
    for (int l = 0; l < NLAYER; ++l) {
        const int p0 = 1 + 8 * l;
        if (IN(p0)) {
            pg8::Gemm g{HN, Wi, NTOK, DIN, DM}; pg8::StaticOrder S; S.init(NTOK, DIN, G, bx);
            pg8::EpiProj E{QK, VTa, rope};
            for (int rep = 0; rep < PROBE_REP_G; ++rep) pg8::gemm_phase<pg8::EpiProj, pg8::StaticOrder, true, true>(lds, g, S, E);
            SEAM(p0);
        }
        if (IN(p0 + 1)) {
            const att::Lane L = att::make_lane();
            for (int rep = 0; rep < PROBE_REP_A; ++rep)
            for (int it = vcu; it < 256; it += G) {
                const int combo = it >> 3, s = it & 7, b = combo >> 3, h = (combo >> 1) & 3, n = combo & 1;
                att::attnA_item(lds, L, QK, VTa, OA, b, h, n, 15 - s);
                att::attnA_item(lds, L, QK, VTa, OA, b, h, n, s);
            }
            for (int rep = 0; rep < PROBE_REP_B; ++rep)
            for (int it = vcu; it < 256; it += G) {
                const int b = it >> 6, h = (it >> 4) & 3, qblk = it & 15;
                att::attnB_item(lds, L, QK, VTb, CAT, a.relb + (size_t)l * 4 * 257, a.gnb + l * 256, b, h, qblk);
            }
            for (int rep = 0; rep < PROBE_REP_C; ++rep)
            for (int it = vcu; it < 256; it += G) {
                const int b = it >> 6, h = (it >> 4) & 3, qblk = it & 15;
                att::attnC_item(lds, L, QK, VTc, CAT, a.gnc + l * 256, b, h, qblk);
            }
            SEAM(p0 + 1);
        }
        if (IN(p0 + 2)) {
            FRESH_IDS();
            const float li = (l == 0) ? a.lam_init[0] : a.lam_init[1];
            const float s1 = wave_sum(a.lq1[l * 64 + lane] * a.lk1[l * 64 + lane]), s2 = wave_sum(a.lq2[l * 64 + lane] * a.lk2[l * 64 + lane]);
            const float lam = expf(s1) - expf(s2) + li;
            combine_pass(OA, CAT, a.subln + l * 128, lam, 1.0f - li, gw, NGW, lane);
            SEAM(p0 + 2);
        }
        if (IN(p0 + 3)) {
            pg8::Gemm g{CAT, Wo, NTOK, DM, DM}; pg8::StaticOrder S; S.init(NTOK, DM, G, bx);
            pg8::EpiY E{Y, DM};
            for (int rep = 0; rep < PROBE_REP_G; ++rep) pg8::gemm_phase<pg8::EpiY, pg8::StaticOrder, true, true>(lds, g, S, E);
            SEAM(p0 + 3);
        }
        if (IN(p0 + 4)) {
            FRESH_IDS();
#if PROBE_PASS
            postnorm_pass(Y, l == 0 ? a.x : a.out, OA, a.g_post_mix + l * DM, a.g_pre_mlp + l * DM, CAT, gw, NGW, lane);
#endif
            postnorm_pass(Y, l == 0 ? a.x : a.out, a.out, a.g_post_mix + l * DM, a.g_pre_mlp + l * DM, HN, gw, NGW, lane);
            SEAM(p0 + 4);
        }
        if (IN(p0 + 5)) {
            pg8::Gemm g{HN, Wu, NTOK, DFF, DM}; pg8::StaticOrder S; S.init(NTOK, DFF, G, bx);
            pg8::EpiRelu2 E{U, DFF};
            for (int rep = 0; rep < PROBE_REP_G; ++rep) pg8::gemm_phase<pg8::EpiRelu2, pg8::StaticOrder, true, true>(lds, g, S, E);
            SEAM(p0 + 5);
        }
        if (IN(p0 + 6)) {
            pg8::Gemm g{U, Wd, NTOK, DM, DFF}; pg8::StaticOrder S; S.init(NTOK, DM, G, bx);
            pg8::EpiY E{Y, DM};
            for (int rep = 0; rep < PROBE_REP_G; ++rep) pg8::gemm_phase<pg8::EpiY, pg8::StaticOrder, true, true>(lds, g, S, E);
            SEAM(p0 + 6);
        }
        if (IN(p0 + 7)) {
            FRESH_IDS();
#if PROBE_PASS
            postnorm_pass(Y, a.out, OA, a.g_post_mlp + l * DM, (l + 1 < NLAYER) ? a.g_pre_mix + (l + 1) * DM : nullptr, CAT, gw, NGW, lane);
#endif
            postnorm_pass(Y, a.out, a.out, a.g_post_mlp + l * DM, (l + 1 < NLAYER) ? a.g_pre_mix + (l + 1) * DM : nullptr, HN, gw, NGW, lane);
            if (l + 1 < NLAYER) convert_weights(a, l + 1, lds, gw, NGW, wave, lane);
            SEAM(p0 + 7);
        }
    }
#undef IN
#undef SEAM
}

extern "C" void kernel_launch(void* const* d_in, const int* in_sizes, int n_in, void* d_out, int out_size, void* d_ws, size_t ws_size, hipStream_t stream) {
    static int grid_blocks = 0;
    if (grid_blocks == 0) {
        if (n_in != 17 || ws_size < WS_END) { fprintf(stderr, "kernel_launch: unexpected inputs (n_in %d, ws %zu)\n", n_in, ws_size); grid_blocks = -1; return; }
        int dev = 0, cus = 0, per_cu = 0;
        hipGetDevice(&dev);
        hipDeviceGetAttribute(&cus, hipDeviceAttributeMultiprocessorCount, dev);
        if (hipFuncSetAttribute((const void*)mk_fwd, hipFuncAttributeMaxDynamicSharedMemorySize, LDS_BYTES) != hipSuccess) fprintf(stderr, "kernel_launch: hipFuncSetAttribute failed\n");
        if (hipOccupancyMaxActiveBlocksPerMultiprocessor(&per_cu, (const void*)mk_fwd, 512, LDS_BYTES) != hipSuccess || per_cu < 1) { fprintf(stderr, "kernel_launch: occupancy query gave %d\n", per_cu); per_cu = 1; }
        (void)hipGetLastError();
        grid_blocks = cus * per_cu;
        if (grid_blocks % 8 != 0 || grid_blocks > 1024) grid_blocks = cus;
    }
    if (grid_blocks < 0) return;
    if (hipMemsetAsync(d_ws, 0, 16384, stream) != hipSuccess) fprintf(stderr, "kernel_launch: hipMemsetAsync failed\n");
    Args a{};
    a.x = (const float*)d_in[0]; a.g_pre_mix = (const float*)d_in[1]; a.w_in = (const float*)d_in[2]; a.lq1 = (const float*)d_in[3]; a.lk1 = (const float*)d_in[4];
    a.lq2 = (const float*)d_in[5]; a.lk2 = (const float*)d_in[6]; a.subln = (const float*)d_in[7]; a.relb = (const float*)d_in[8]; a.gnb = (const float*)d_in[9];
    a.gnc = (const float*)d_in[10]; a.w_out = (const float*)d_in[11]; a.g_post_mix = (const float*)d_in[12]; a.g_pre_mlp = (const float*)d_in[13];
    a.w_up = (const float*)d_in[14]; a.w_down = (const float*)d_in[15]; a.g_post_mlp = (const float*)d_in[16];
    a.out = (float*)d_out; a.ws = (unsigned char*)d_ws;
    for (int j = 0; j < 8; ++j) a.inv_freq[j] = powf(500000.0f, -(float)(2 * j) / 16.0f);
    for (int l = 0; l < 2; ++l) a.lam_init[l] = (float)(0.8 - 0.6 * exp(-0.3 * (double)l));
    a.pad = 0;
#if MK_SPLIT
    a.coop = 0;
    for (int ph = 0; ph < NPHASE; ++ph) { a.ph_lo = ph; a.ph_hi = ph + 1; hipLaunchKernelGGL(mk_fwd, dim3(grid_blocks), dim3(512), LDS_BYTES, stream, a); }
#else
    a.coop = 1; a.ph_lo = 0; a.ph_hi = NPHASE;
    void* args[] = {&a};
    hipError_t e = hipLaunchCooperativeKernel((const void*)mk_fwd, dim3(grid_blocks), dim3(512), args, LDS_BYTES, stream);
    if (e != hipSuccess) fprintf(stderr, "cooperative launch failed: %s (grid %d)\n", hipGetErrorString(e), grid_blocks);
#endif
}
```

```cpp
#include <hip/hip_runtime.h>
#include <hip/hip_cooperative_groups.h>
#include <cstdio>
#include <cstdint>
#include <cmath>
namespace cg = cooperative_groups;
#ifndef MK_SPLIT
#define MK_SPLIT 0
#endif

#ifndef PROBE_REP_A
#define PROBE_REP_A 1
#endif
#ifndef PROBE_REP_B
#define PROBE_REP_B 1
#endif
#ifndef PROBE_REP_C
#define PROBE_REP_C 1
#endif
#ifndef PROBE_REP_G
#define PROBE_REP_G 1
#endif
#ifndef PROBE_PASS
#define PROBE_PASS 0
#endif
constexpr int SEQ = 4096, NBATCH = 4, DM = 1024, DFF = 4096, DIN = 3072, NTOK = NBATCH * SEQ, NLAYER = 2;
constexpr int QKP = 2048;
constexpr size_t VTB_OFF = (size_t)8 << 20, VTC_OFF = (size_t)12 << 20;
constexpr float RMS_EPS = 1e-6f;
constexpr float LOG2E = 1.4426950408889634f;
constexpr float QSCALE = 0.125f * LOG2E;

#define LAS __attribute__((address_space(3)))
__device__ __forceinline__ int fresh_tid() { int t = threadIdx.x; asm volatile("" : "+v"(t)); return t; }

namespace pg8 {
#define PG8_LAS __attribute__((address_space(3)))
typedef unsigned short bf16_t;
typedef short bf16x8 __attribute__((ext_vector_type(8)));
typedef float f32x4 __attribute__((ext_vector_type(4)));
typedef unsigned u32x4 __attribute__((ext_vector_type(4)));
constexpr int BM = 256, BK = 64, HALF = 128, HTB = HALF * BK * 2  , STAGE_BYTES = 8 * HTB, NXCD = 8, WGM = 8;

__host__ __device__ __forceinline__ int lds_byte(int r, int c) { const int st = (r >> 4) * 2 + (c >> 5), rr = r & 15, cc = c & 31, ob = rr * 64 + cc * 2; return st * 1024 + (ob ^ (((ob >> 9) & 1) << 5)); }
__host__ __device__ __forceinline__ void stage_rc(int b, int& R, int& C) { const int st = b / 1024, sb = b % 1024, swz = sb ^ (((sb >> 9) & 1) << 5); R = (st >> 1) * 16 + swz / 64; C = (st & 1) * 32 + (swz % 64) / 2; }
__host__ __device__ __forceinline__ int perm32(int rho) { const int n = rho >> 4, i = rho & 15; return 8 * (i >> 2) + 4 * n + (i & 3); }

struct Unit { int pm, pn; };
struct Gemm { const bf16_t* A; const bf16_t* Bt; int M, N, K; };

struct StaticOrder {
    int nM, nN, nwg, G, c;
    __host__ __device__ void init(int M, int N, int G_, int c_) { nM = M / BM; nN = N / BM; nwg = nM * nN; G = G_; c = c_; }
    __host__ __device__ bool next(int i, Unit& u) const {
        const long L = (long)i * G + c; if (L >= nwg) return false;
        int wgid = (int)L; { const int q = nwg / NXCD, r = nwg % NXCD, xcd = wgid % NXCD, off = wgid / NXCD; wgid = (xcd < r ? xcd * (q + 1) : r * (q + 1) + (xcd - r) * q) + off; }
        const int nig = WGM * nN, gid = wgid / nig, fm = gid * WGM, gsz = (nM - fm) < WGM ? (nM - fm) : WGM;
        u.pm = fm + ((wgid % nig) % gsz); u.pn = (wgid % nig) / gsz; return true;
    }
    __device__ __forceinline__ void a_ready(const Unit&) const {}
    __device__ __forceinline__ void done(const Unit&) const {}
};

__device__ __forceinline__ unsigned cvt_pk_bf16(float lo, float hi) { unsigned r; asm volatile("v_cvt_pk_bf16_f32 %0, %1, %2" : "=v"(r) : "v"(lo), "v"(hi)); return r; }
typedef float f32x2 __attribute__((ext_vector_type(2)));
typedef float f32x2 __attribute__((ext_vector_type(2)));
typedef __bf16 bf16x2_t __attribute__((ext_vector_type(2)));
__device__ __forceinline__ unsigned cvtpk(float lo, float hi) { f32x2 v = {lo, hi}; bf16x2_t b = __builtin_convertvector(v, bf16x2_t); return __builtin_bit_cast(unsigned, b); }
__device__ __forceinline__ bf16_t cvt1(float v) { return (bf16_t)(cvtpk(v, 0.f) & 0xffffu); }

struct EpiProj {
    static constexpr bool PERM = true, AFTER_DRAIN = false;
    bf16_t* QK; bf16_t* VT; const float* rope;
    __device__ __forceinline__ void operator()(const f32x4 (&acc)[2][2][4][2], const Unit& u, int wr, int wc, int fr, int fq) const {
        const int pn = u.pn;
        const int row0 = u.pm * BM + wr * 64 + fr;
        const int cin = wc * 32 + 8 * fq;
        if (pn == 4 || pn == 5 || pn == 8 || pn == 11) {
            const size_t voff = (pn <= 5) ? (size_t)0 : (pn == 8 ? VTB_OFF : VTC_OFF);
            bf16_t* base = VT + voff;
            const int nd = (pn <= 5) ? 128 : 64, c0 = (pn == 5) ? 256 : 0;
#pragma unroll
            for (int ai = 0; ai < 2; ++ai)
#pragma unroll
                for (int m = 0; m < 4; ++m) {
                    const int row = row0 + ai * HALF + m * 16, b = row >> 12, s = row & (SEQ - 1);
#pragma unroll
                    for (int bj = 0; bj < 2; ++bj) {
                        const int c = c0 + bj * HALF + cin;
                        const int h = c / nd, e = c % nd;
                        bf16_t* p = base + ((size_t)((b * 4 + h) * nd + e)) * SEQ + s;
#pragma unroll
                        for (int n = 0; n < 2; ++n)
#pragma unroll
                            for (int i = 0; i < 4; ++i) p[(size_t)(4 * n + i) * SEQ] = cvt1(acc[ai][bj][m][n][i]);
                    }
                }
            return;
        }
        int dcol; bool rope_on = false; float sc = 1.f;
        if (pn <= 1) { dcol = pn * 256; rope_on = true; sc = QSCALE; }
        else if (pn <= 3) { dcol = 512 + (pn - 2) * 256; rope_on = true; }
        else if (pn == 6) { dcol = 1024; sc = QSCALE; }
        else if (pn == 7) { dcol = 1280; }
        else if (pn == 9) { dcol = 1536; sc = QSCALE; }
        else { dcol = 1792; }
        const bool rl = ((wc & 1) == 0) && (fq < 2);
#pragma unroll
        for (int ai = 0; ai < 2; ++ai)
#pragma unroll
            for (int m = 0; m < 4; ++m) {
                const int row = row0 + ai * HALF + m * 16;
#pragma unroll
                for (int bj = 0; bj < 2; ++bj) {
                    f32x4 v0 = acc[ai][bj][m][0], v1 = acc[ai][bj][m][1];
                    if (rope_on) {
                        f32x4 o0, o1;
#pragma unroll
                        for (int i = 0; i < 4; ++i) { o0[i] = __shfl_xor(v0[i], 16); o1[i] = __shfl_xor(v1[i], 16); }
                        if (rl) {
                            const f32x4* t = (const f32x4*)(rope + (size_t)(row & (SEQ - 1)) * 16);
                            const f32x4 c0 = t[0], c1 = t[1], s0 = t[2], s1 = t[3];
                            if (fq == 0) { v0 = v0 * c0 - o0 * s0; v1 = v1 * c1 - o1 * s1; }
                            else         { v0 = v0 * c0 + o0 * s0; v1 = v1 * c1 + o1 * s1; }
                        }
                    }
                    v0 = v0 * sc; v1 = v1 * sc;
                    u32x4 w; w.x = cvtpk(v0[0], v0[1]); w.y = cvtpk(v0[2], v0[3]); w.z = cvtpk(v1[0], v1[1]); w.w = cvtpk(v1[2], v1[3]);
                    *(u32x4*)(QK + (size_t)row * QKP + dcol + bj * HALF + cin) = w;
                }
            }
    }
};
struct EpiY {
    static constexpr bool PERM = true, AFTER_DRAIN = false;
    bf16_t* O; int ldc;
    __device__ __forceinline__ void operator()(const f32x4 (&acc)[2][2][4][2], const Unit& u, int wr, int wc, int fr, int fq) const {
        const int row0 = u.pm * BM + wr * 64 + fr, col0 = u.pn * BM + wc * 32 + 8 * fq;
#pragma unroll
        for (int ai = 0; ai < 2; ++ai)
#pragma unroll
            for (int m = 0; m < 4; ++m) { bf16_t* rowp = O + (size_t)(row0 + ai * HALF + m * 16) * ldc + col0;
#pragma unroll
                for (int bj = 0; bj < 2; ++bj) { const f32x4 v0 = acc[ai][bj][m][0], v1 = acc[ai][bj][m][1];
                    u32x4 w; w.x = cvtpk(v0[0], v0[1]); w.y = cvtpk(v0[2], v0[3]); w.z = cvtpk(v1[0], v1[1]); w.w = cvtpk(v1[2], v1[3]);
                    *(u32x4*)(rowp + bj * HALF) = w; } }
    }
};
struct EpiRelu2 {
    static constexpr bool PERM = true, AFTER_DRAIN = false;
    bf16_t* O; int ldc;
    __device__ __forceinline__ void operator()(const f32x4 (&acc)[2][2][4][2], const Unit& u, int wr, int wc, int fr, int fq) const {
        const int row0 = u.pm * BM + wr * 64 + fr, col0 = u.pn * BM + wc * 32 + 8 * fq;
#pragma unroll
        for (int ai = 0; ai < 2; ++ai)
#pragma unroll
            for (int m = 0; m < 4; ++m) { bf16_t* rowp = O + (size_t)(row0 + ai * HALF + m * 16) * ldc + col0;
#pragma unroll
                for (int bj = 0; bj < 2; ++bj) { f32x4 v0 = acc[ai][bj][m][0], v1 = acc[ai][bj][m][1];
#pragma unroll
                    for (int i = 0; i < 4; ++i) { const float a = fmaxf(v0[i], 0.f), b = fmaxf(v1[i], 0.f); v0[i] = a * a; v1[i] = b * b; }
                    u32x4 w; w.x = cvtpk(v0[0], v0[1]); w.y = cvtpk(v0[2], v0[3]); w.z = cvtpk(v1[0], v1[1]); w.w = cvtpk(v1[2], v1[3]);
                    *(u32x4*)(rowp + bj * HALF) = w; } }
    }
};

template <class Epi, class Sched, bool ALIGN_EPI = false, bool SP2 = false>
__device__ __forceinline__ void gemm_phase(PG8_LAS unsigned char* lds, const Gemm g, const Sched& S, const Epi& E) {
    const int tid = fresh_tid(), wid = __builtin_amdgcn_readfirstlane(tid >> 6), lane = tid & 63, wr = wid >> 2, wc = wid & 3, fr = lane & 15, fq = lane >> 4;
    const int K = g.K, nt = K / BK;
    unsigned voffA[2], voffB[2];
#pragma unroll
    for (int i = 0; i < 2; ++i) { int R, C; stage_rc(tid * 16 + i * 8192, R, C); const int Rb = Epi::PERM ? ((R & ~31) + perm32(R & 31)) : R;
        voffA[i] = (unsigned)(R * K + C) * 2u; voffB[i] = (unsigned)(Rb * K + C) * 2u; }
    const size_t kstep = (size_t)(BK * 2);
    const size_t hstep = (size_t)HALF * K * 2;
    const size_t tstep = 2 * hstep;
    const unsigned ldsw = (unsigned)wid * 1024u;
    const int aoff = lds_byte(wr * 64 + fr, fq * 8), boff = lds_byte(wc * 32 + fr, fq * 8);
#define PG8_SA(b, h) (((b) * 2 + (h)) * HTB)
#define PG8_SB(b, h) ((4 + (b) * 2 + (h)) * HTB)
#define PG8_STAGE(bufoff, gbase, voff) do { _Pragma("unroll") for (int _i = 0; _i < 2; ++_i) \
        __builtin_amdgcn_global_load_lds((const unsigned*)((const char*)(gbase) + (voff)[_i]), (PG8_LAS unsigned*)(lds + (bufoff) + ldsw + _i * 8192), 16, 0, 0); } while (0)
#define PG8_LDA(dst, b, h) do { _Pragma("unroll") for (int m = 0; m < 4; ++m) _Pragma("unroll") for (int k = 0; k < 2; ++k) dst[m][k] = *(const PG8_LAS bf16x8*)(lds + PG8_SA(b, h) + aoff + m * 2048 + k * 1024); } while (0)
#define PG8_LDB(dst, b, h) do { _Pragma("unroll") for (int n = 0; n < 2; ++n) _Pragma("unroll") for (int k = 0; k < 2; ++k) dst[n][k] = *(const PG8_LAS bf16x8*)(lds + PG8_SB(b, h) + boff + n * 2048 + k * 1024); } while (0)
#define PG8_MMA(ai, bj, At, Bt) do { __builtin_amdgcn_s_setprio(1); _Pragma("unroll") for (int m = 0; m < 4; ++m) _Pragma("unroll") for (int n = 0; n < 2; ++n) _Pragma("unroll") for (int k = 0; k < 2; ++k) \
        acc[ai][bj][m][n] = __builtin_amdgcn_mfma_f32_16x16x32_bf16(Bt[n][k], At[m][k], acc[ai][bj][m][n], 0, 0, 0); __builtin_amdgcn_s_setprio(0); } while (0)
#define PG8_WAIT_V(n) asm volatile("s_waitcnt vmcnt(" #n ")" ::: "memory")
#define PG8_WAIT_L(n) asm volatile("s_waitcnt lgkmcnt(" #n ")" ::: "memory")
#define PG8_BAR __builtin_amdgcn_s_barrier()
#define PG8_SCHED __builtin_amdgcn_sched_barrier(0)
    Unit cur, nxt; int ui = 0;
    if (!S.next(0, cur)) return;
    f32x4 acc[2][2][4][2];
#pragma unroll
    for (int a = 0; a < 2; ++a)
#pragma unroll
        for (int b = 0; b < 2; ++b)
#pragma unroll
            for (int m = 0; m < 4; ++m)
#pragma unroll
                for (int n = 0; n < 2; ++n) acc[a][b][m][n] = (f32x4){0.f, 0.f, 0.f, 0.f};
    bf16x8 At[4][2], B0[2][2], B1[2][2];
    const char* cA = (const char*)g.A + (size_t)cur.pm * tstep; const char* cB = (const char*)g.Bt + (size_t)cur.pn * tstep;
    S.a_ready(cur);
    if constexpr (SP2) {
        PG8_STAGE(PG8_SB(0, 0), cB, voffB); PG8_STAGE(PG8_SB(0, 1), cB + hstep, voffB); PG8_STAGE(PG8_SA(0, 0), cA, voffA); PG8_STAGE(PG8_SA(0, 1), cA + hstep, voffA);
        if (wr == 1) PG8_BAR;
        PG8_WAIT_V(2); PG8_BAR;
        PG8_STAGE(PG8_SB(1, 0), cB + kstep, voffB); PG8_STAGE(PG8_SA(1, 0), cA + kstep, voffA); PG8_STAGE(PG8_SB(1, 1), cB + hstep + kstep, voffB);
        PG8_WAIT_V(6); PG8_BAR;
    } else {
        PG8_STAGE(PG8_SB(0, 0), cB, voffB); PG8_STAGE(PG8_SA(0, 0), cA, voffA); PG8_STAGE(PG8_SB(0, 1), cB + hstep, voffB); PG8_STAGE(PG8_SA(0, 1), cA + hstep, voffA);
        if (wr == 1) PG8_BAR;
        PG8_WAIT_V(4); PG8_BAR;
        PG8_STAGE(PG8_SB(1, 0), cB + kstep, voffB); PG8_STAGE(PG8_SA(1, 0), cA + kstep, voffA); PG8_STAGE(PG8_SB(1, 1), cB + hstep + kstep, voffB);
        PG8_WAIT_V(6); PG8_BAR;
    }
    for (;;) {
        const bool has_next = S.next(ui + 1, nxt);
        const char* nA = has_next ? (const char*)g.A + (size_t)nxt.pm * tstep : cA; const char* nB = has_next ? (const char*)g.Bt + (size_t)nxt.pn * tstep : cB;
        for (int t = 0; t < nt; t += 2) {
            const bool last = (t == nt - 2);
            const char* a1 = cA + (size_t)(t + 1) * kstep;
            const char* a2 = last ? nA : cA + (size_t)(t + 2) * kstep; const char* b2 = last ? nB : cB + (size_t)(t + 2) * kstep;
            const char* a3 = a2 + kstep; const char* b3 = b2 + kstep;
            if (last && has_next) S.a_ready(nxt);
            if constexpr (SP2) {
            PG8_LDB(B0, 0, 0); PG8_LDB(B1, 0, 1); PG8_SCHED; PG8_LDA(At, 0, 0); PG8_STAGE(PG8_SA(1, 1), a1 + hstep, voffA);
            PG8_WAIT_V(8); PG8_WAIT_L(0); PG8_BAR; PG8_MMA(0, 0, At, B0); PG8_MMA(0, 1, At, B1); PG8_BAR; PG8_SCHED;
            PG8_LDA(At, 0, 1); PG8_STAGE(PG8_SB(0, 0), b2, voffB); PG8_STAGE(PG8_SB(0, 1), b2 + hstep, voffB); PG8_STAGE(PG8_SA(0, 0), a2, voffA);
            PG8_WAIT_V(8); PG8_WAIT_L(0); PG8_BAR; PG8_MMA(1, 0, At, B0); PG8_MMA(1, 1, At, B1); PG8_BAR; PG8_SCHED;
            PG8_LDB(B0, 1, 0); PG8_LDB(B1, 1, 1); PG8_SCHED; PG8_LDA(At, 1, 0); PG8_STAGE(PG8_SA(0, 1), a2 + hstep, voffA);
            PG8_WAIT_V(8); PG8_WAIT_L(0); PG8_BAR; PG8_MMA(0, 0, At, B0); PG8_MMA(0, 1, At, B1); PG8_BAR; PG8_SCHED;
            PG8_LDA(At, 1, 1); PG8_STAGE(PG8_SB(1, 0), b3, voffB); PG8_STAGE(PG8_SB(1, 1), b3 + hstep, voffB); PG8_STAGE(PG8_SA(1, 0), a3, voffA);
            PG8_WAIT_V(8); PG8_WAIT_L(0); PG8_BAR; PG8_MMA(1, 0, At, B0); PG8_MMA(1, 1, At, B1); PG8_BAR; PG8_SCHED;
            } else {
            PG8_LDB(B0, 0, 0); PG8_SCHED; PG8_LDA(At, 0, 0); PG8_STAGE(PG8_SA(1, 1), a1 + hstep, voffA);
            PG8_WAIT_L(8); PG8_BAR; PG8_WAIT_L(0); PG8_MMA(0, 0, At, B0); PG8_BAR; PG8_SCHED;
            PG8_LDB(B1, 0, 1); PG8_STAGE(PG8_SB(0, 0), b2, voffB);
            PG8_BAR; PG8_WAIT_L(0); PG8_MMA(0, 1, At, B1); PG8_BAR;
            PG8_LDA(At, 0, 1); PG8_STAGE(PG8_SA(0, 0), a2, voffA);
            PG8_BAR; PG8_WAIT_L(0); PG8_MMA(1, 0, At, B0); PG8_BAR; PG8_SCHED;
            PG8_STAGE(PG8_SB(0, 1), b2 + hstep, voffB);
            PG8_WAIT_V(6); PG8_BAR; PG8_MMA(1, 1, At, B1); PG8_BAR;
            PG8_LDB(B0, 1, 0); PG8_SCHED; PG8_LDA(At, 1, 0); PG8_STAGE(PG8_SA(0, 1), a2 + hstep, voffA);
            PG8_WAIT_L(8); PG8_BAR; PG8_WAIT_L(0); PG8_MMA(0, 0, At, B0); PG8_BAR; PG8_SCHED;
            PG8_LDB(B1, 1, 1); PG8_STAGE(PG8_SB(1, 0), b3, voffB);
            PG8_BAR; PG8_WAIT_L(0); PG8_MMA(0, 1, At, B1); PG8_BAR;
            PG8_LDA(At, 1, 1); PG8_STAGE(PG8_SA(1, 0), a3, voffA);
            PG8_BAR; PG8_WAIT_L(0); PG8_MMA(1, 0, At, B0); PG8_BAR; PG8_SCHED;
            PG8_STAGE(PG8_SB(1, 1), b3 + hstep, voffB);
            PG8_WAIT_V(6); PG8_BAR; PG8_MMA(1, 1, At, B1); PG8_BAR;
            }
        }
        if constexpr (ALIGN_EPI) { if (wr == 0) PG8_BAR; }
        if constexpr (!Epi::AFTER_DRAIN) { E(acc, cur, wr, wc, fr, fq); S.done(cur); }
        if (!has_next) break;
#pragma unroll
        for (int a = 0; a < 2; ++a)
#pragma unroll
            for (int b = 0; b < 2; ++b)
#pragma unroll
                for (int m = 0; m < 4; ++m)
#pragma unroll
                    for (int n = 0; n < 2; ++n) acc[a][b][m][n] = (f32x4){0.f, 0.f, 0.f, 0.f};
        cur = nxt; cA = nA; cB = nB; ++ui;
        if constexpr (ALIGN_EPI) { if (wr == 1) PG8_BAR; }
    }
    PG8_WAIT_V(0);
    if constexpr (!ALIGN_EPI) { if (wr == 0) PG8_BAR; }
    PG8_BAR;
    if constexpr (Epi::AFTER_DRAIN) { E.fused(acc, cur, wr, wc, fr, fq, lds, wid, lane); S.done(cur); }
#undef PG8_SA
#undef PG8_SB
#undef PG8_STAGE
#undef PG8_LDA
#undef PG8_LDB
#undef PG8_MMA
#undef PG8_WAIT_V
#undef PG8_WAIT_L
#undef PG8_BAR
#undef PG8_SCHED
}
}
#define XB_TMO      128
#define XB_XCNT(j)  (256  + 64 * (j))
#define XB_XSUB(j)  (1280 + 64 * (j))
#define XB_XGEN(j)  (2304 + 64 * (j))
#define XB_TOP      3328
#define XB_TOPGEN   3392
#define XCD_BAR_WORDS 3456
#define XB_SPIN_CAP (1u << 18)

__device__ __forceinline__ unsigned xb_ld(unsigned* p)              { return __hip_atomic_load(p, __ATOMIC_RELAXED, __HIP_MEMORY_SCOPE_AGENT); }
__device__ __forceinline__ unsigned xb_add(unsigned* p, unsigned v) { return __hip_atomic_fetch_add(p, v, __ATOMIC_RELAXED, __HIP_MEMORY_SCOPE_AGENT); }
__device__ __forceinline__ unsigned xb_xcc_id() { return (unsigned)__builtin_amdgcn_s_getreg((3 << 11) | 20) & 0xFu; }
#define XB_SPIN(cond, bar) do { unsigned _sp = 0; while (cond) { __builtin_amdgcn_s_sleep(1); \
    if ((++_sp & 255u) == 0u) { if (xb_ld(&(bar)[XB_TMO])) break; if (_sp > XB_SPIN_CAP) { atomicAdd(&(bar)[XB_TMO], 1u); break; } } } } while (0)

struct XcdBarrier {
    unsigned* bar; unsigned x;
    volatile LAS unsigned* st;
};

__device__ __forceinline__ XcdBarrier xcd_barrier_post(unsigned* bar, volatile LAS unsigned* st) {
    XcdBarrier b; b.bar = bar; b.x = xb_xcc_id(); b.st = st;
    if (threadIdx.x == 0) (void)xb_add(&bar[XB_XCNT(b.x)], 1u);
    return b;
}
__device__ __forceinline__ void xcd_barrier_complete(unsigned* bar, unsigned x, unsigned& nloc, unsigned& nx) {
    const unsigned G = gridDim.x * gridDim.y * gridDim.z;
    unsigned sum, cnt, mine, sp = 0u;
    for (;;) {
        sum = 0u; cnt = 0u; mine = 0u;
#pragma unroll
        for (unsigned j = 0; j < 16; ++j) { const unsigned c = xb_ld(&bar[XB_XCNT(j)]); sum += c; cnt += (c > 0u) ? 1u : 0u; mine = (j == x) ? c : mine; }
        if (sum == G) break;
        __builtin_amdgcn_s_sleep(1);
        if ((++sp & 255u) == 0u) { if (xb_ld(&bar[XB_TMO])) break; if (sp > XB_SPIN_CAP) { atomicAdd(&bar[XB_TMO], 1u); break; } }
    }
    nloc = mine > 0u ? mine : 1u; nx = cnt > 0u ? cnt : 1u;
}

__device__ __forceinline__ void xcd_barrier(const XcdBarrier& b) {
    asm volatile("s_waitcnt vmcnt(0)" ::: "memory");
    __syncthreads();
    if (threadIdx.x == 0) {
        unsigned* bar = b.bar;
        __builtin_amdgcn_s_waitcnt(0);
        unsigned nloc = b.st[0], nx = b.st[1];
        if (nloc == 0u) { xcd_barrier_complete(bar, b.x, nloc, nx); b.st[0] = nloc; b.st[1] = nx; }
        const unsigned old = xb_add(&bar[XB_XSUB(b.x)], 1u);
        const unsigned gen = old / nloc;
        if (old + 1u == (gen + 1u) * nloc) {
            __builtin_amdgcn_fence(__ATOMIC_RELEASE, "agent");
            asm volatile("s_waitcnt vmcnt(0)" ::: "memory");
            const unsigned og = xb_add(&bar[XB_TOP], 1u);
            const unsigned tg = og / nx;
            if (og + 1u == (tg + 1u) * nx) xb_add(&bar[XB_TOPGEN], 1u);
            else XB_SPIN(xb_ld(&bar[XB_TOPGEN]) == tg, bar);
            __builtin_amdgcn_fence(__ATOMIC_ACQUIRE, "agent");
            xb_add(&bar[XB_XGEN(b.x)], 1u);
            asm volatile("s_waitcnt vmcnt(0)" ::: "memory");
        } else {
            XB_SPIN(xb_ld(&bar[XB_XGEN(b.x)]) == gen, bar);
            __builtin_amdgcn_fence(__ATOMIC_ACQUIRE, "agent");
            asm volatile("s_waitcnt vmcnt(0)" ::: "memory");
        }
    }
    __syncthreads();
}

typedef unsigned short bf16_t;
typedef short bf16x8 __attribute__((ext_vector_type(8)));
typedef float f32x4 __attribute__((ext_vector_type(4)));
typedef float f32x16 __attribute__((ext_vector_type(16)));
typedef unsigned u32x4 __attribute__((ext_vector_type(4)));
typedef unsigned u32x2 __attribute__((ext_vector_type(2)));
using pg8::cvtpk;
#define MFMA32(a, b, c) __builtin_amdgcn_mfma_f32_32x32x16_bf16((a), (b), (c), 0, 0, 0)
__device__ __forceinline__ float wave_sum(float v) {
#pragma unroll
    for (int o = 1; o < 64; o <<= 1) v += __shfl_xor(v, o);
    return v;
}
__device__ __forceinline__ float ex2(float x) { return __builtin_amdgcn_exp2f(x); }
__device__ __forceinline__ float lg2(float x) { return __builtin_amdgcn_logf(x); }

constexpr size_t MiB = 1u << 20;
constexpr size_t WS_ROPE = 1 * MiB;
constexpr size_t WS_WI = 2 * MiB, WS_WO = 8 * MiB, WS_WU = 10 * MiB, WS_WD = 18 * MiB;
constexpr size_t WS_HN = 26 * MiB;
constexpr size_t WS_Y = 58 * MiB;
constexpr size_t WS_QK = 58 * MiB;
constexpr size_t WS_U = 122 * MiB;
constexpr size_t WS_VTA = 122 * MiB, WS_VTB = 138 * MiB, WS_VTC = 146 * MiB;
constexpr size_t WS_OA = 154 * MiB;
constexpr size_t WS_CAT = 218 * MiB;
constexpr size_t WS_END = 250 * MiB;
static_assert(WS_VTB - WS_VTA == VTB_OFF * 2 && WS_VTC - WS_VTA == VTC_OFF * 2, "V^T offsets");

namespace att {
constexpr int KROW = 144;
constexpr int KBUF = 64 * KROW, VBUF = 128 * KROW;
constexpr int L_K0 = 0, L_K1 = KBUF, L_V0 = 2 * KBUF, L_V1 = 2 * KBUF + VBUF, L_MISC = 2 * KBUF + 2 * VBUF;
constexpr int L_RB = L_MISC, L_FLAG = L_MISC + 2048;

template <int DV> struct TileRegs { u32x4 k; u32x4 v[DV / 64]; };
template <int DV> __device__ __forceinline__ void tile_load(TileRegs<DV>& r, const bf16_t* Kb, const bf16_t* Vb, int key0, int tid) {
    const int row = tid >> 3, ch = tid & 7;
    r.k = *(const u32x4*)(Kb + (size_t)(key0 + row) * QKP + ch * 8);
#pragma unroll
    for (int i = 0; i < DV / 64; ++i) r.v[i] = *(const u32x4*)(Vb + (size_t)(row + 64 * i) * SEQ + key0 + ch * 8);
}
template <int DV> __device__ __forceinline__ void tile_store(const TileRegs<DV>& r, LAS unsigned char* lds, int kbuf, int vbuf, int tid) {
    const int row = tid >> 3, ch = tid & 7;
    *(LAS u32x4*)(lds + kbuf + row * KROW + ch * 16) = r.k;
#pragma unroll
    for (int i = 0; i < DV / 64; ++i) *(LAS u32x4*)(lds + vbuf + (row + 64 * i) * KROW + ch * 16) = r.v[i];
}
__device__ __forceinline__ void qk_tile(f32x16& s0, f32x16& s1, LAS const unsigned char* kp, const bf16x8 (&q)[4]) {
#pragma unroll
    for (int i = 0; i < 16; ++i) { s0[i] = 0.f; s1[i] = 0.f; }
    bf16x8 a0[4], a1[4];
#pragma unroll
    for (int d0 = 0; d0 < 4; ++d0) { a0[d0] = *(LAS const bf16x8*)(kp + d0 * 32); a1[d0] = *(LAS const bf16x8*)(kp + 32 * KROW + d0 * 32); }
#pragma unroll
    for (int d0 = 0; d0 < 4; ++d0) { s0 = MFMA32(a0[d0], q[d0], s0); s1 = MFMA32(a1[d0], q[d0], s1); }
}
__device__ __forceinline__ bf16x8 pack8(const f32x16& s, int b) {
    u32x4 w; w.x = cvtpk(s[b], s[b + 1]); w.y = cvtpk(s[b + 2], s[b + 3]); w.z = cvtpk(s[b + 4], s[b + 5]); w.w = cvtpk(s[b + 6], s[b + 7]);
    return __builtin_bit_cast(bf16x8, w);
}
template <int NDB> __device__ __forceinline__ void pv_tile(f32x16 (&o)[NDB], LAS const unsigned char* vp, const bf16x8 (&pf)[4]) {
#pragma unroll
    for (int dp = 0; dp < NDB; dp += 2) {
        bf16x8 a[8];
#pragma unroll
        for (int i = 0; i < 8; ++i) a[i] = *(LAS const bf16x8*)(vp + (dp + (i >> 2)) * 32 * KROW + (i & 3) * 32);
#pragma unroll
        for (int kg = 0; kg < 4; ++kg) { o[dp] = MFMA32(a[kg], pf[kg], o[dp]); o[dp + 1] = MFMA32(a[4 + kg], pf[kg], o[dp + 1]); }
    }
}
template <int NDB> __device__ __forceinline__ void softmax_update(f32x16& s0, f32x16& s1, float& m, float& l, f32x16 (&o)[NDB], LAS const unsigned char* vp) {
    float mx = fmaxf(s0[0], s1[0]);
#pragma unroll
    for (int i = 1; i < 16; ++i) mx = fmaxf(mx, fmaxf(s0[i], s1[i]));
    mx = fmaxf(mx, __shfl_xor(mx, 32));
    const float mn = fmaxf(m, mx), alpha = ex2(m - mn); m = mn;
    float ps = 0.f;
#pragma unroll
    for (int i = 0; i < 16; ++i) { s0[i] = ex2(s0[i] - mn); s1[i] = ex2(s1[i] - mn); ps += s0[i] + s1[i]; }
    l = l * alpha + ps;
#pragma unroll
    for (int db = 0; db < NDB; ++db) o[db] = o[db] * alpha;
    bf16x8 pf[4]; pf[0] = pack8(s0, 0); pf[1] = pack8(s0, 8); pf[2] = pack8(s1, 0); pf[3] = pack8(s1, 8);
    pv_tile<NDB>(o, vp, pf);
}
struct Lane { int tid, wid, lane, rho, hi, koff, voff; };
__device__ __forceinline__ Lane make_lane() {
    Lane L; L.tid = fresh_tid(); L.wid = __builtin_amdgcn_readfirstlane(L.tid >> 6); L.lane = L.tid & 63; L.rho = L.lane & 31; L.hi = L.lane >> 5;
    const int pr = (L.rho & ~12) | ((L.rho & 4) << 1) | ((L.rho & 8) >> 1);
    L.koff = pr * KROW + L.hi * 16; L.voff = L.rho * KROW + L.hi * 16; return L;
}
__device__ __forceinline__ void load_q(bf16x8 (&q)[4], const bf16_t* Qrow  ) {
#pragma unroll
    for (int d0 = 0; d0 < 4; ++d0) q[d0] = *(const bf16x8*)(Qrow + d0 * 16);
}

constexpr int STG_A = KBUF + VBUF;
__device__ __forceinline__ void qk_tile_ref(f32x16& s0, f32x16& s1, LAS const unsigned char* kp, const bf16x8 (&q)[4], float negm) {
#pragma unroll
    for (int i = 0; i < 16; ++i) { s0[i] = negm; s1[i] = negm; }
    bf16x8 a0[4], a1[4];
#pragma unroll
    for (int d0 = 0; d0 < 4; ++d0) { a0[d0] = *(LAS const bf16x8*)(kp + d0 * 32); a1[d0] = *(LAS const bf16x8*)(kp + 32 * KROW + d0 * 32); }
#pragma unroll
    for (int d0 = 0; d0 < 4; ++d0) { s0 = MFMA32(a0[d0], q[d0], s0); s1 = MFMA32(a1[d0], q[d0], s1); }
}
template <int NDB, bool HAS_NEXT> __device__ __forceinline__ void sm_tile(f32x16& s0, f32x16& s1, f32x16& n0, f32x16& n1, bool first, float& m, float& l, f32x16 (&o)[NDB], LAS const unsigned char* vp) {
    float mx = fmaxf(s0[0], s1[0]);
#pragma unroll
    for (int i = 1; i < 16; ++i) mx = fmaxf(mx, fmaxf(s0[i], s1[i]));
    mx = fmaxf(mx, __shfl_xor(mx, 32));
    if (first || __any(mx > 8.0f)) {
        const float dl = first ? mx : fmaxf(mx, 0.f);
        m += dl; s0 = s0 - dl; s1 = s1 - dl;
        if (HAS_NEXT) { n0 = n0 - dl; n1 = n1 - dl; }
        if (!first) { const float alpha = ex2(-dl); l *= alpha;
#pragma unroll
            for (int db = 0; db < NDB; ++db) o[db] = o[db] * alpha; }
    }
    float ps = 0.f;
#pragma unroll
    for (int i = 0; i < 16; ++i) { s0[i] = ex2(s0[i]); s1[i] = ex2(s1[i]); }
#pragma unroll
    for (int i = 0; i < 16; ++i) ps += s0[i] + s1[i];
    l += ps;
    bf16x8 pf[4]; pf[0] = pack8(s0, 0); pf[1] = pack8(s0, 8); pf[2] = pack8(s1, 0); pf[3] = pack8(s1, 8);
    pv_tile<NDB>(o, vp, pf);
}
__device__ __forceinline__ void attnA_item(LAS unsigned char* lds, const Lane& L, const bf16_t* QK, const bf16_t* VTa, float* OA, int b, int h, int n, int qblk) {
    const int rowq = qblk * 256 + L.wid * 32, cw = rowq >> 6;
    const size_t tok0 = (size_t)b * SEQ;
    bf16x8 q[4]; load_q(q, QK + (tok0 + rowq + L.rho) * QKP + h * 128 + n * 64 + L.hi * 8);
    const bf16_t* Kb = QK + tok0 * QKP + 512 + h * 128 + n * 64;
    const bf16_t* Vb = VTa + (size_t)((b * 4 + h) * 128) * SEQ;
    const int NT = 4 * qblk + 4;
    TileRegs<128> tr;
    tile_load<128>(tr, Kb, Vb, 0, L.tid); tile_store<128>(tr, lds, 0, KBUF, L.tid); __syncthreads();
    float m = 0.f, l = 0.f; f32x16 o[4];
#pragma unroll
    for (int db = 0; db < 4; ++db)
#pragma unroll
        for (int i = 0; i < 16; ++i) o[db][i] = 0.f;
    int sc = 0, sn = STG_A;
    for (int t = 0; t < NT; ++t) {
        if (t + 1 < NT) tile_load<128>(tr, Kb, Vb, (t + 1) * 64, L.tid);
        if (t <= cw) {
            f32x16 c0, c1; qk_tile_ref(c0, c1, lds + sc + L.koff, q, -m);
            sm_tile<4, false>(c0, c1, c0, c1, t == 0, m, l, o, lds + sc + KBUF + L.voff);
        }
        if (t + 1 < NT) tile_store<128>(tr, lds, sn, sn + KBUF, L.tid);
        __syncthreads();
        const int tmp = sc; sc = sn; sn = tmp;
    }
    l += __shfl_xor(l, 32);
    const float inv = 1.0f / l;
    float* op = OA + ((size_t)n * NTOK + tok0 + rowq + L.rho) * 512 + h * 128 + 4 * L.hi;
#pragma unroll
    for (int db = 0; db < 4; ++db)
#pragma unroll
        for (int g = 0; g < 4; ++g) { f32x4 v = {o[db][4 * g], o[db][4 * g + 1], o[db][4 * g + 2], o[db][4 * g + 3]}; *(f32x4*)(op + db * 32 + 8 * g) = v * inv; }
}
__device__ __forceinline__ void store_head_norm(const f32x16 (&o)[2], const Lane& L, const float* gain  , bf16_t* dst  ) {
    float ss = 0.f;
#pragma unroll
    for (int db = 0; db < 2; ++db)
#pragma unroll
        for (int i = 0; i < 16; ++i) ss += o[db][i] * o[db][i];
    ss += __shfl_xor(ss, 32);
    const float rs = rsqrtf(ss * (1.0f / 64.0f) + RMS_EPS);
#pragma unroll
    for (int db = 0; db < 2; ++db)
#pragma unroll
        for (int g = 0; g < 4; ++g) { const int d = db * 32 + 8 * g + 4 * L.hi; const f32x4 gv = *(const f32x4*)(gain + d);
            u32x2 w; w.x = cvtpk(o[db][4 * g] * rs * gv[0], o[db][4 * g + 1] * rs * gv[1]); w.y = cvtpk(o[db][4 * g + 2] * rs * gv[2], o[db][4 * g + 3] * rs * gv[3]);
            *(u32x2*)(dst + d) = w; }
}
__device__ __forceinline__ void attnB_item(LAS unsigned char* lds, const Lane& L, const bf16_t* QK, const bf16_t* VTb, bf16_t* CAT, const float* relb  , const float* gnb, int b, int h, int qblk) {
    const int rowq = qblk * 256 + L.wid * 32, cw = rowq >> 6;
    const size_t tok0 = (size_t)b * SEQ;
    LAS float* rb = (LAS float*)(lds + L_RB);
    if (L.tid < 257) rb[L.tid] = relb[h * 257 + L.tid] * LOG2E;
    bf16x8 q[4]; load_q(q, QK + (tok0 + rowq + L.rho) * QKP + 1024 + h * 64 + L.hi * 8);
    const bf16_t* Kb = QK + tok0 * QKP + 1280 + h * 64;
    const bf16_t* Vb = VTb + (size_t)((b * 4 + h) * 64) * SEQ;
    const int t_lo = (4 * qblk - 8) > 0 ? (4 * qblk - 8) : 0, t_hi = 4 * qblk + 3;
    TileRegs<64> tr;
    tile_load<64>(tr, Kb, Vb, t_lo * 64, L.tid); tile_store<64>(tr, lds, L_K0, L_V0, L.tid); __syncthreads();
    float m = -1e30f, l = 0.f; f32x16 o[2];
#pragma unroll
    for (int db = 0; db < 2; ++db)
#pragma unroll
        for (int i = 0; i < 16; ++i) o[db][i] = 0.f;
    const int qpos = rowq + L.rho;
    for (int t = t_lo; t <= t_hi; ++t) {
        const int cur = (t - t_lo) & 1;
        if (t < t_hi) tile_load<64>(tr, Kb, Vb, (t + 1) * 64, L.tid);
        if (t <= cw && t >= cw - 8) {
            f32x16 s0, s1; qk_tile(s0, s1, lds + (cur ? L_K1 : L_K0) + L.koff, q);
            if (cw - t >= 3) {
                const float bc = rb[256];
#pragma unroll
                for (int i = 0; i < 16; ++i) { s0[i] += bc; s1[i] += bc; }
            } else {
                const int rel0 = qpos - (t * 64 + 8 * L.hi);
#pragma unroll
                for (int r = 0; r < 16; ++r) { const int ko = 16 * (r >> 3) + (r & 7);
                    int i0 = rel0 - ko; i0 = (i0 > 128 ? 128 : i0) + 128; int i1 = rel0 - 32 - ko; i1 = (i1 > 128 ? 128 : i1) + 128;
                    s0[r] += rb[i0]; s1[r] += rb[i1]; }
            }
            softmax_update<2>(s0, s1, m, l, o, lds + (cur ? L_V1 : L_V0) + L.voff);
        }
        if (t < t_hi) tile_store<64>(tr, lds, cur ? L_K0 : L_K1, cur ? L_V0 : L_V1, L.tid);
        __syncthreads();
    }
    l += __shfl_xor(l, 32);
    const float inv = 1.0f / l;
#pragma unroll
    for (int db = 0; db < 2; ++db) o[db] = o[db] * inv;
    store_head_norm(o, L, gnb + h * 64, CAT + (tok0 + rowq + L.rho) * 1024 + 512 + h * 64);
}
__device__ __forceinline__ void stick_block(const f32x16& y, int kbase, int lim, int hi, float& R, bf16x8& pf0, bf16x8& pf1) {
    f32x16 ls, lb;
#pragma unroll
    for (int r = 0; r < 16; ++r) {
        const int kpos = kbase + 16 * (r >> 3) + 8 * hi + (r & 7);
        const float yy = y[r], sp = fmaxf(yy, 0.f) + lg2(1.0f + ex2(-fabsf(yy)));
        const bool valid = kpos < lim;
        ls[r] = valid ? -sp : 0.f;
        lb[r] = valid ? (yy - sp) : -1e30f;
    }
    float g0 = 0.f, g1 = 0.f;
#pragma unroll
    for (int i = 0; i < 8; ++i) { g0 += ls[i]; g1 += ls[8 + i]; }
    const float p0 = __shfl_xor(g0, 32), p1 = __shfl_xor(g1, 32);
    const float G11 = hi ? g1 : p1, G01 = hi ? p1 : g1, G10 = hi ? g0 : p0, G00 = hi ? p0 : g0;
    float run1 = R + (hi ? 0.f : G11);
    float run0 = R + (G11 + G01) + (hi ? 0.f : G10);
    f32x16 a;
#pragma unroll
    for (int i = 7; i >= 0; --i) {
        a[8 + i] = ex2(lb[8 + i] + run1); run1 += ls[8 + i];
        a[i] = ex2(lb[i] + run0); run0 += ls[i];
    }
    R += (G11 + G01) + (G10 + G00);
    pf0 = pack8(a, 0); pf1 = pack8(a, 8);
}
__device__ __forceinline__ void attnC_item(LAS unsigned char* lds, const Lane& L, const bf16_t* QK, const bf16_t* VTc, bf16_t* CAT, const float* gnc, int b, int h, int qblk) {
    const int rowq = qblk * 256 + L.wid * 32, cw = rowq >> 6;
    const size_t tok0 = (size_t)b * SEQ;
    volatile LAS unsigned* flag = (volatile LAS unsigned*)(lds + L_FLAG);
    bf16x8 q[4]; load_q(q, QK + (tok0 + rowq + L.rho) * QKP + 1536 + h * 64 + L.hi * 8);
    const bf16_t* Kb = QK + tok0 * QKP + 1792 + h * 64;
    const bf16_t* Vb = VTc + (size_t)((b * 4 + h) * 64) * SEQ;
    const int t_hi = 4 * qblk + 3;
    TileRegs<64> tr;
    tile_load<64>(tr, Kb, Vb, t_hi * 64, L.tid); tile_store<64>(tr, lds, L_K0, L_V0, L.tid); __syncthreads();
    float R = 0.f; f32x16 o[2];
#pragma unroll
    for (int db = 0; db < 2; ++db)
#pragma unroll
        for (int i = 0; i < 16; ++i) o[db][i] = 0.f;
    const int qpos = rowq + L.rho;
    bool wdone = false;
    for (int t = t_hi; t >= 0; --t) {
        const int it = t_hi - t, cur = it & 1;
        if (t > 0) tile_load<64>(tr, Kb, Vb, (t - 1) * 64, L.tid);
        if (t <= cw && !wdone) {
            f32x16 s0, s1; qk_tile(s0, s1, lds + (cur ? L_K1 : L_K0) + L.koff, q);
            const int lim = (t == cw) ? qpos : 0x7fffffff;
            bf16x8 pf[4];
            stick_block(s1, t * 64 + 32, lim, L.hi, R, pf[2], pf[3]);
            stick_block(s0, t * 64, lim, L.hi, R, pf[0], pf[1]);
            pv_tile<2>(o, lds + (cur ? L_V1 : L_V0) + L.voff, pf);
            wdone = __all(R < -150.0f) != 0;
        }
        if (L.lane == 0) flag[cur * 8 + L.wid] = (wdone || t == 0) ? 1u : 0u;
        if (t > 0) tile_store<64>(tr, lds, cur ? L_K0 : L_K1, cur ? L_V0 : L_V1, L.tid);
        __syncthreads();
        unsigned alld = 1u;
#pragma unroll
        for (int w = 0; w < 8; ++w) alld &= flag[cur * 8 + w];
        if (alld) break;
    }
    __syncthreads();
    store_head_norm(o, L, gnc + h * 64, CAT + (tok0 + rowq + L.rho) * 1024 + 768 + h * 64);
}
}

__device__ __forceinline__ void store_row_bf16(bf16_t* orow, const f32x4 (&v)[4], int lane) {
#pragma unroll
    for (int j = 0; j < 4; ++j) { u32x2 w; w.x = cvtpk(v[j][0], v[j][1]); w.y = cvtpk(v[j][2], v[j][3]); *((u32x2*)orow + lane + 64 * j) = w; }
}
__device__ __forceinline__ void prenorm_pass(const float* x, const float* g, bf16_t* HN, int gw, int NGW, int lane) {
    for (int m = gw; m < NTOK; m += NGW) {
        const f32x4* xr = (const f32x4*)(x + (size_t)m * DM) + lane; f32x4 v[4]; float s = 0.f;
#pragma unroll
        for (int j = 0; j < 4; ++j) { v[j] = xr[64 * j]; s += (v[j][0] * v[j][0] + v[j][1] * v[j][1]) + (v[j][2] * v[j][2] + v[j][3] * v[j][3]); }
        const float rs = rsqrtf(wave_sum(s) * (1.0f / DM) + RMS_EPS);
#pragma unroll
        for (int j = 0; j < 4; ++j) v[j] = v[j] * rs * ((const f32x4*)g)[lane + 64 * j];
        store_row_bf16(HN + (size_t)m * DM, v, lane);
    }
}
__device__ __forceinline__ void postnorm_pass(const bf16_t* Y, const float* xin, float* xout, const float* gpost, const float* gnext, bf16_t* HN, int gw, int NGW, int lane) {
    for (int m = gw; m < NTOK; m += NGW) {
        const u32x2* yr = (const u32x2*)(Y + (size_t)m * DM) + lane; const f32x4* xr = (const f32x4*)(xin + (size_t)m * DM) + lane;
        f32x4 y[4], v[4]; float s = 0.f;
#pragma unroll
        for (int j = 0; j < 4; ++j) { const u32x2 w = yr[64 * j]; v[j] = xr[64 * j];
            y[j][0] = __uint_as_float(w.x << 16); y[j][1] = __uint_as_float(w.x & 0xffff0000u); y[j][2] = __uint_as_float(w.y << 16); y[j][3] = __uint_as_float(w.y & 0xffff0000u);
            s += (y[j][0] * y[j][0] + y[j][1] * y[j][1]) + (y[j][2] * y[j][2] + y[j][3] * y[j][3]); }
        const float rs = rsqrtf(wave_sum(s) * (1.0f / DM) + RMS_EPS);
        float s2 = 0.f;
#pragma unroll
        for (int j = 0; j < 4; ++j) { v[j] = v[j] + y[j] * rs * ((const f32x4*)gpost)[lane + 64 * j]; s2 += (v[j][0] * v[j][0] + v[j][1] * v[j][1]) + (v[j][2] * v[j][2] + v[j][3] * v[j][3]); }
        f32x4* xo = (f32x4*)(xout + (size_t)m * DM) + lane;
#pragma unroll
        for (int j = 0; j < 4; ++j) xo[64 * j] = v[j];
        if (gnext) {
            const float rs2 = rsqrtf(wave_sum(s2) * (1.0f / DM) + RMS_EPS);
#pragma unroll
            for (int j = 0; j < 4; ++j) v[j] = v[j] * rs2 * ((const f32x4*)gnext)[lane + 64 * j];
            store_row_bf16(HN + (size_t)m * DM, v, lane);
        }
    }
}
__device__ __forceinline__ void combine_pass(const float* OA, bf16_t* CAT, const float* subln, float lam, float oscale, int gw, int NGW, int lane) {
    const int e0 = (lane & 15) * 8;
    const f32x4 g0 = *(const f32x4*)(subln + e0), g1 = *(const f32x4*)(subln + e0 + 4);
    for (int m = gw; m < NTOK; m += NGW) {
        const f32x4* a = (const f32x4*)(OA + (size_t)m * 512) + 2 * lane; const f32x4* c = (const f32x4*)(OA + ((size_t)NTOK + m) * 512) + 2 * lane;
        f32x4 d0 = a[0] - c[0] * lam, d1 = a[1] - c[1] * lam;
        float ss = (d0[0] * d0[0] + d0[1] * d0[1]) + (d0[2] * d0[2] + d0[3] * d0[3]) + (d1[0] * d1[0] + d1[1] * d1[1]) + (d1[2] * d1[2] + d1[3] * d1[3]);
#pragma unroll
        for (int o = 1; o < 16; o <<= 1) ss += __shfl_xor(ss, o);
        const float rs = rsqrtf(ss * (1.0f / 128.0f) + RMS_EPS) * oscale;
        d0 = d0 * rs * g0; d1 = d1 * rs * g1;
        u32x4 w; w.x = cvtpk(d0[0], d0[1]); w.y = cvtpk(d0[2], d0[3]); w.z = cvtpk(d1[0], d1[1]); w.w = cvtpk(d1[2], d1[3]);
        *((u32x4*)(CAT + (size_t)m * 1024) + lane) = w;
    }
}
__device__ __forceinline__ void transpose_item(const float* W, int K, int N, bf16_t* WT, LAS float* scr, int item, int lane) {
    const int nblk = N / 32, kb = item / nblk, nb = item % nblk, k0 = 64 * kb, n0 = 32 * nb;
#pragma unroll 8
    for (int i = 0; i < 32; ++i) { const int kk = 2 * i + (lane >> 5); scr[kk * 33 + (lane & 31)] = W[(size_t)(k0 + kk) * N + n0 + (lane & 31)]; }
    asm volatile("s_waitcnt lgkmcnt(0)" ::: "memory");
    const int c = lane & 7;
#pragma unroll
    for (int j = 0; j < 4; ++j) { const int n = (lane >> 3) + 8 * j; const LAS float* s = scr + (8 * c) * 33 + n;
        u32x4 o; o.x = cvtpk(s[0 * 33], s[1 * 33]); o.y = cvtpk(s[2 * 33], s[3 * 33]); o.z = cvtpk(s[4 * 33], s[5 * 33]); o.w = cvtpk(s[6 * 33], s[7 * 33]);
        *(u32x4*)(WT + (size_t)(n0 + n) * K + k0 + 8 * c) = o; }
    asm volatile("s_waitcnt lgkmcnt(0)" ::: "memory");
}

struct Args {
    const float* x; const float* g_pre_mix; const float* w_in; const float* lq1; const float* lk1; const float* lq2; const float* lk2;
    const float* subln; const float* relb; const float* gnb; const float* gnc; const float* w_out; const float* g_post_mix; const float* g_pre_mlp;
    const float* w_up; const float* w_down; const float* g_post_mlp;
    float* out; unsigned char* ws;
    float inv_freq[8]; float lam_init[2]; int ph_lo, ph_hi, coop, pad;
};
constexpr int NPHASE = 1 + 8 * NLAYER;
constexpr int LDS_BYTES = 147456;

__device__ __forceinline__ void convert_weights(const Args& a, int l, LAS unsigned char* lds, int gw, int NGW, int wave, int lane) {
    LAS float* scr = (LAS float*)(lds + wave * 16384);
    constexpr int I_IN = (DM / 64) * (DIN / 32), I_O = (DM / 64) * (DM / 32), I_U = (DM / 64) * (DFF / 32), I_D = (DFF / 64) * (DM / 32);
    constexpr int NITEMS = I_IN + I_O + I_U + I_D;
    bf16_t* Wi = (bf16_t*)(a.ws + WS_WI); bf16_t* Wo = (bf16_t*)(a.ws + WS_WO); bf16_t* Wu = (bf16_t*)(a.ws + WS_WU); bf16_t* Wd = (bf16_t*)(a.ws + WS_WD);
    for (int it = gw; it < NITEMS; it += NGW) {
        int r = it;
        if (r < I_IN) { transpose_item(a.w_in + (size_t)l * DM * DIN, DM, DIN, Wi, scr, r, lane); continue; } r -= I_IN;
        if (r < I_O) { transpose_item(a.w_out + (size_t)l * DM * DM, DM, DM, Wo, scr, r, lane); continue; } r -= I_O;
        if (r < I_U) { transpose_item(a.w_up + (size_t)l * DM * DFF, DM, DFF, Wu, scr, r, lane); continue; } r -= I_U;
        transpose_item(a.w_down + (size_t)l * DFF * DM, DFF, DM, Wd, scr, r, lane);
    }
}

__global__ void __launch_bounds__(512, 2) mk_fwd(Args a) {
    extern __shared__ __attribute__((aligned(16))) unsigned char lds_raw[];
    LAS unsigned char* lds = (LAS unsigned char*)lds_raw;
    cg::grid_group grid = cg::this_grid();
    const int G = gridDim.x, bx = blockIdx.x;
    const int vcu = (G % 8 == 0) ? (bx % 8) * (G / 8) + bx / 8 : bx;
    const int NGW = G * 8;
#define FRESH_IDS() const int tid = fresh_tid(), lane = tid & 63, wave = __builtin_amdgcn_readfirstlane(tid >> 6), gw = vcu * 8 + wave; (void)tid; (void)lane; (void)gw
    unsigned char* ws = a.ws;
    bf16_t* Wi = (bf16_t*)(ws + WS_WI); bf16_t* Wo = (bf16_t*)(ws + WS_WO); bf16_t* Wu = (bf16_t*)(ws + WS_WU); bf16_t* Wd = (bf16_t*)(ws + WS_WD);
    bf16_t* HN = (bf16_t*)(ws + WS_HN); bf16_t* Y = (bf16_t*)(ws + WS_Y); bf16_t* QK = (bf16_t*)(ws + WS_QK); bf16_t* U = (bf16_t*)(ws + WS_U);
    bf16_t* VTa = (bf16_t*)(ws + WS_VTA); bf16_t* VTb = (bf16_t*)(ws + WS_VTB); bf16_t* VTc = (bf16_t*)(ws + WS_VTC);
    float* OA = (float*)(ws + WS_OA); bf16_t* CAT = (bf16_t*)(ws + WS_CAT); float* rope = (float*)(ws + WS_ROPE);

    const int lo = a.ph_lo, hi = a.ph_hi;
    volatile LAS unsigned* bst = (volatile LAS unsigned*)(lds + LDS_BYTES - 64);
    if (threadIdx.x < 16) bst[threadIdx.x] = 0u;
    __syncthreads();
    XcdBarrier bar; bar.bar = (unsigned*)ws; bar.x = 0; bar.st = bst;
    if (a.coop) bar = xcd_barrier_post((unsigned*)ws, bst);
    if (a.pad == 0x7fffffff) grid.sync();
#define IN(p) (lo <= (p) && (p) < hi)
#define SEAM(p) do { if (IN((p) + 1) && a.coop) xcd_barrier(bar); } while (0)
    if (IN(0)) {
        FRESH_IDS();
        convert_weights(a, 0, lds, gw, NGW, wave, lane);
        for (int p = bx * 512 + tid; p < SEQ; p += G * 512) {
            f32x4 c[2], s[2];
#pragma unroll
            for (int j = 0; j < 8; ++j) {
                const float ang = (float)p * a.inv_freq[j];
                double t = (double)ang * 0.15915494309189535; t -= rint(t);
                const float tf = (float)t;
                c[j >> 2][j & 3] = __builtin_amdgcn_cosf(tf); s[j >> 2][j & 3] = __builtin_amdgcn_sinf(tf);
            }
            f32x4* o = (f32x4*)(rope + (size_t)p * 16); o[0] = c[0]; o[1] = c[1]; o[2] = s[0]; o[3] = s[1];
        }
        prenorm_pass(a.x, a.g_pre_mix, HN, gw, NGW, lane);
        SEAM(0);
    }
    for (int l = 0; l < NLAYER; ++l) {
        const int p0 = 1 + 8 * l;
        if (IN(p0)) {
            pg8::Gemm g{HN, Wi, NTOK, DIN, DM}; pg8::StaticOrder S; S.init(NTOK, DIN, G, bx);
            pg8::EpiProj E{QK, VTa, rope};
            for (int rep = 0; rep < PROBE_REP_G; ++rep) pg8::gemm_phase<pg8::EpiProj, pg8::StaticOrder, true, true>(lds, g, S, E);
            SEAM(p0);
        }
        if (IN(p0 + 1)) {
            const att::Lane L = att::make_lane();
            for (int rep = 0; rep < PROBE_REP_A; ++rep)
            for (int it = vcu; it < 256; it += G) {
                const int combo = it >> 3, s = it & 7, b = combo >> 3, h = (combo >> 1) & 3, n = combo & 1;
                for (int j = 0; j < 2; ++j) att::attnA_item(lds, L, QK, VTa, OA, b, h, n, j ? s : 15 - s);
            }
            for (int rep = 0; rep < PROBE_REP_B; ++rep)
            for (int it = vcu; it < 256; it += G) {
                const int b = it >> 6, h = (it >> 4) & 3, qblk = it & 15;
                att::attnB_item(lds, L, QK, VTb, CAT, a.relb + (size_t)l * 4 * 257, a.gnb + l * 256, b, h, qblk);
            }
            for (int rep = 0; rep < PROBE_REP_C; ++rep)
            for (int it = vcu; it < 256; it += G) {
                const int b = it >> 6, h = (it >> 4) & 3, qblk = it & 15;
                att::attnC_item(lds, L, QK, VTc, CAT, a.gnc + l * 256, b, h, qblk);
            }
            SEAM(p0 + 1);
        }
        if (IN(p0 + 2)) {
            FRESH_IDS();
            const float li = (l == 0) ? a.lam_init[0] : a.lam_init[1];
            const float s1 = wave_sum(a.lq1[l * 64 + lane] * a.lk1[l * 64 + lane]), s2 = wave_sum(a.lq2[l * 64 + lane] * a.lk2[l * 64 + lane]);
            const float lam = expf(s1) - expf(s2) + li;
            combine_pass(OA, CAT, a.subln + l * 128, lam, 1.0f - li, gw, NGW, lane);
            SEAM(p0 + 2);
        }
        if (IN(p0 + 3)) {
            pg8::Gemm g{CAT, Wo, NTOK, DM, DM}; pg8::StaticOrder S; S.init(NTOK, DM, G, bx);
            pg8::EpiY E{Y, DM};
            for (int rep = 0; rep < PROBE_REP_G; ++rep) pg8::gemm_phase<pg8::EpiY, pg8::StaticOrder, true, true>(lds, g, S, E);
            SEAM(p0 + 3);
        }
        if (IN(p0 + 4)) {
            FRESH_IDS();
#if PROBE_PASS
            postnorm_pass(Y, l == 0 ? a.x : a.out, OA, a.g_post_mix + l * DM, a.g_pre_mlp + l * DM, CAT, gw, NGW, lane);
#endif
            postnorm_pass(Y, l == 0 ? a.x : a.out, a.out, a.g_post_mix + l * DM, a.g_pre_mlp + l * DM, HN, gw, NGW, lane);
            SEAM(p0 + 4);
        }
        if (IN(p0 + 5)) {
            pg8::Gemm g{HN, Wu, NTOK, DFF, DM}; pg8::StaticOrder S; S.init(NTOK, DFF, G, bx);
            pg8::EpiRelu2 E{U, DFF};
            for (int rep = 0; rep < PROBE_REP_G; ++rep) pg8::gemm_phase<pg8::EpiRelu2, pg8::StaticOrder, true, true>(lds, g, S, E);
            SEAM(p0 + 5);
        }
        if (IN(p0 + 6)) {
            pg8::Gemm g{U, Wd, NTOK, DM, DFF}; pg8::StaticOrder S; S.init(NTOK, DM, G, bx);
            pg8::EpiY E{Y, DM};
            for (int rep = 0; rep < PROBE_REP_G; ++rep) pg8::gemm_phase<pg8::EpiY, pg8::StaticOrder, true, true>(lds, g, S, E);
            SEAM(p0 + 6);
        }
        if (IN(p0 + 7)) {
            FRESH_IDS();
#if PROBE_PASS
            postnorm_pass(Y, a.out, OA, a.g_post_mlp + l * DM, (l + 1 < NLAYER) ? a.g_pre_mix + (l + 1) * DM : nullptr, CAT, gw, NGW, lane);
#endif
            postnorm_pass(Y, a.out, a.out, a.g_post_mlp + l * DM, (l + 1 < NLAYER) ? a.g_pre_mix + (l + 1) * DM : nullptr, HN, gw, NGW, lane);
            if (l + 1 < NLAYER) convert_weights(a, l + 1, lds, gw, NGW, wave, lane);
            SEAM(p0 + 7);
        }
    }
#undef IN
#undef SEAM
}

extern "C" void kernel_launch(void* const* d_in, const int* in_sizes, int n_in, void* d_out, int out_size, void* d_ws, size_t ws_size, hipStream_t stream) {
    static int grid_blocks = 0;
    if (grid_blocks == 0) {
        if (n_in != 17 || ws_size < WS_END) { fprintf(stderr, "kernel_launch: unexpected inputs (n_in %d, ws %zu)\n", n_in, ws_size); grid_blocks = -1; return; }
        int dev = 0, cus = 0, per_cu = 0;
        hipGetDevice(&dev);
        hipDeviceGetAttribute(&cus, hipDeviceAttributeMultiprocessorCount, dev);
        if (hipFuncSetAttribute((const void*)mk_fwd, hipFuncAttributeMaxDynamicSharedMemorySize, LDS_BYTES) != hipSuccess) fprintf(stderr, "kernel_launch: hipFuncSetAttribute failed\n");
        if (hipOccupancyMaxActiveBlocksPerMultiprocessor(&per_cu, (const void*)mk_fwd, 512, LDS_BYTES) != hipSuccess || per_cu < 1) { fprintf(stderr, "kernel_launch: occupancy query gave %d\n", per_cu); per_cu = 1; }
        (void)hipGetLastError();
        grid_blocks = cus * per_cu;
        if (grid_blocks % 8 != 0 || grid_blocks > 1024) grid_blocks = cus;
    }
    if (grid_blocks < 0) return;
    if (hipMemsetAsync(d_ws, 0, 16384, stream) != hipSuccess) fprintf(stderr, "kernel_launch: hipMemsetAsync failed\n");
    Args a{};
    a.x = (const float*)d_in[0]; a.g_pre_mix = (const float*)d_in[1]; a.w_in = (const float*)d_in[2]; a.lq1 = (const float*)d_in[3]; a.lk1 = (const float*)d_in[4];
    a.lq2 = (const float*)d_in[5]; a.lk2 = (const float*)d_in[6]; a.subln = (const float*)d_in[7]; a.relb = (const float*)d_in[8]; a.gnb = (const float*)d_in[9];
    a.gnc = (const float*)d_in[10]; a.w_out = (const float*)d_in[11]; a.g_post_mix = (const float*)d_in[12]; a.g_pre_mlp = (const float*)d_in[13];
    a.w_up = (const float*)d_in[14]; a.w_down = (const float*)d_in[15]; a.g_post_mlp = (const float*)d_in[16];
    a.out = (float*)d_out; a.ws = (unsigned char*)d_ws;
    for (int j = 0; j < 8; ++j) a.inv_freq[j] = powf(500000.0f, -(float)(2 * j) / 16.0f);
    for (int l = 0; l < 2; ++l) a.lam_init[l] = (float)(0.8 - 0.6 * exp(-0.3 * (double)l));
    a.pad = 0;
#if MK_SPLIT
    a.coop = 0;
    for (int ph = 0; ph < NPHASE; ++ph) { a.ph_lo = ph; a.ph_hi = ph + 1; hipLaunchKernelGGL(mk_fwd, dim3(grid_blocks), dim3(512), LDS_BYTES, stream, a); }
#else
    a.coop = 1; a.ph_lo = 0; a.ph_hi = NPHASE;
    void* args[] = {&a};
    hipError_t e = hipLaunchCooperativeKernel((const void*)mk_fwd, dim3(grid_blocks), dim3(512), args, LDS_BYTES, stream);
    if (e != hipSuccess) fprintf(stderr, "cooperative launch failed: %s (grid %d)\n", hipGetErrorString(e), grid_blocks);
#endif
}
```

```cpp
#include <hip/hip_runtime.h>
#include <hip/hip_cooperative_groups.h>
#include <cstdio>
#include <cstdint>
#include <cmath>
namespace cg = cooperative_groups;
#ifndef MK_SPLIT
#define MK_SPLIT 0
#endif

#ifndef PROBE_REP_A
#define PROBE_REP_A 1
#endif
#ifndef PROBE_REP_B
#define PROBE_REP_B 1
#endif
#ifndef PROBE_REP_C
#define PROBE_REP_C 1
#endif
#ifndef PROBE_REP_G
#define PROBE_REP_G 1
#endif
#ifndef PROBE_PASS
#define PROBE_PASS 0
#endif
constexpr int SEQ = 4096, NBATCH = 4, DM = 1024, DFF = 4096, DIN = 3072, NTOK = NBATCH * SEQ, NLAYER = 2;
constexpr int QKP = 2048;
constexpr size_t VTB_OFF = (size_t)8 << 20, VTC_OFF = (size_t)12 << 20;
constexpr float RMS_EPS = 1e-6f;
constexpr float LOG2E = 1.4426950408889634f;
constexpr float QSCALE = 0.125f * LOG2E;

#define LAS __attribute__((address_space(3)))
__device__ __forceinline__ int fresh_tid() { int t = threadIdx.x; asm volatile("" : "+v"(t)); return t; }

namespace pg8 {
#define PG8_LAS __attribute__((address_space(3)))
typedef unsigned short bf16_t;
typedef short bf16x8 __attribute__((ext_vector_type(8)));
typedef float f32x4 __attribute__((ext_vector_type(4)));
typedef unsigned u32x4 __attribute__((ext_vector_type(4)));
constexpr int BM = 256, BK = 64, HALF = 128, HTB = HALF * BK * 2  , STAGE_BYTES = 8 * HTB, NXCD = 8, WGM = 8;

__host__ __device__ __forceinline__ int lds_byte(int r, int c) { const int st = (r >> 4) * 2 + (c >> 5), rr = r & 15, cc = c & 31, ob = rr * 64 + cc * 2; return st * 1024 + (ob ^ (((ob >> 9) & 1) << 5)); }
__host__ __device__ __forceinline__ void stage_rc(int b, int& R, int& C) { const int st = b / 1024, sb = b % 1024, swz = sb ^ (((sb >> 9) & 1) << 5); R = (st >> 1) * 16 + swz / 64; C = (st & 1) * 32 + (swz % 64) / 2; }
__host__ __device__ __forceinline__ int perm32(int rho) { const int n = rho >> 4, i = rho & 15; return 8 * (i >> 2) + 4 * n + (i & 3); }

struct Unit { int pm, pn; };
struct Gemm { const bf16_t* A; const bf16_t* Bt; int M, N, K; };

struct StaticOrder {
    int nM, nN, nwg, G, c;
    __host__ __device__ void init(int M, int N, int G_, int c_) { nM = M / BM; nN = N / BM; nwg = nM * nN; G = G_; c = c_; }
    __host__ __device__ bool next(int i, Unit& u) const {
        const long L = (long)i * G + c; if (L >= nwg) return false;
        int wgid = (int)L; { const int q = nwg / NXCD, r = nwg % NXCD, xcd = wgid % NXCD, off = wgid / NXCD; wgid = (xcd < r ? xcd * (q + 1) : r * (q + 1) + (xcd - r) * q) + off; }
        const int nig = WGM * nN, gid = wgid / nig, fm = gid * WGM, gsz = (nM - fm) < WGM ? (nM - fm) : WGM;
        u.pm = fm + ((wgid % nig) % gsz); u.pn = (wgid % nig) / gsz; return true;
    }
    __device__ __forceinline__ void a_ready(const Unit&) const {}
    __device__ __forceinline__ void done(const Unit&) const {}
};

__device__ __forceinline__ unsigned cvt_pk_bf16(float lo, float hi) { unsigned r; asm volatile("v_cvt_pk_bf16_f32 %0, %1, %2" : "=v"(r) : "v"(lo), "v"(hi)); return r; }
typedef float f32x2 __attribute__((ext_vector_type(2)));
typedef float f32x2 __attribute__((ext_vector_type(2)));
typedef __bf16 bf16x2_t __attribute__((ext_vector_type(2)));
__device__ __forceinline__ unsigned cvtpk(float lo, float hi) { f32x2 v = {lo, hi}; bf16x2_t b = __builtin_convertvector(v, bf16x2_t); return __builtin_bit_cast(unsigned, b); }
__device__ __forceinline__ bf16_t cvt1(float v) { return (bf16_t)(cvtpk(v, 0.f) & 0xffffu); }

struct EpiProj {
    static constexpr bool PERM = true, AFTER_DRAIN = false;
    bf16_t* QK; bf16_t* VT; const float* rope;
    __device__ __forceinline__ void operator()(const f32x4 (&acc)[2][2][4][2], const Unit& u, int wr, int wc, int fr, int fq) const {
        const int pn = u.pn;
        const int row0 = u.pm * BM + wr * 64 + fr;
        const int cin = wc * 32 + 8 * fq;
        if (pn == 4 || pn == 5 || pn == 8 || pn == 11) {
            const size_t voff = (pn <= 5) ? (size_t)0 : (pn == 8 ? VTB_OFF : VTC_OFF);
            bf16_t* base = VT + voff;
            const int nd = (pn <= 5) ? 128 : 64, c0 = (pn == 5) ? 256 : 0;
#pragma unroll
            for (int ai = 0; ai < 2; ++ai)
#pragma unroll
                for (int m = 0; m < 4; ++m) {
                    const int row = row0 + ai * HALF + m * 16, b = row >> 12, s = row & (SEQ - 1);
#pragma unroll
                    for (int bj = 0; bj < 2; ++bj) {
                        const int c = c0 + bj * HALF + cin;
                        const int h = c / nd, e = c % nd;
                        bf16_t* p = base + ((size_t)((b * 4 + h) * nd + e)) * SEQ + s;
#pragma unroll
                        for (int n = 0; n < 2; ++n)
#pragma unroll
                            for (int i = 0; i < 4; ++i) p[(size_t)(4 * n + i) * SEQ] = cvt1(acc[ai][bj][m][n][i]);
                    }
                }
            return;
        }
        int dcol; bool rope_on = false; float sc = 1.f;
        if (pn <= 1) { dcol = pn * 256; rope_on = true; sc = QSCALE; }
        else if (pn <= 3) { dcol = 512 + (pn - 2) * 256; rope_on = true; }
        else if (pn == 6) { dcol = 1024; sc = QSCALE; }
        else if (pn == 7) { dcol = 1280; }
        else if (pn == 9) { dcol = 1536; sc = QSCALE; }
        else { dcol = 1792; }
        const bool rl = ((wc & 1) == 0) && (fq < 2);
#pragma unroll
        for (int ai = 0; ai < 2; ++ai)
#pragma unroll
            for (int m = 0; m < 4; ++m) {
                const int row = row0 + ai * HALF + m * 16;
#pragma unroll
                for (int bj = 0; bj < 2; ++bj) {
                    f32x4 v0 = acc[ai][bj][m][0], v1 = acc[ai][bj][m][1];
                    if (rope_on) {
                        f32x4 o0, o1;
#pragma unroll
                        for (int i = 0; i < 4; ++i) { o0[i] = __shfl_xor(v0[i], 16); o1[i] = __shfl_xor(v1[i], 16); }
                        if (rl) {
                            const f32x4* t = (const f32x4*)(rope + (size_t)(row & (SEQ - 1)) * 16);
                            const f32x4 c0 = t[0], c1 = t[1], s0 = t[2], s1 = t[3];
                            if (fq == 0) { v0 = v0 * c0 - o0 * s0; v1 = v1 * c1 - o1 * s1; }
                            else         { v0 = v0 * c0 + o0 * s0; v1 = v1 * c1 + o1 * s1; }
                        }
                    }
                    v0 = v0 * sc; v1 = v1 * sc;
                    u32x4 w; w.x = cvtpk(v0[0], v0[1]); w.y = cvtpk(v0[2], v0[3]); w.z = cvtpk(v1[0], v1[1]); w.w = cvtpk(v1[2], v1[3]);
                    *(u32x4*)(QK + (size_t)row * QKP + dcol + bj * HALF + cin) = w;
                }
            }
    }
};
struct EpiY {
    static constexpr bool PERM = true, AFTER_DRAIN = false;
    bf16_t* O; int ldc;
    __device__ __forceinline__ void operator()(const f32x4 (&acc)[2][2][4][2], const Unit& u, int wr, int wc, int fr, int fq) const {
        const int row0 = u.pm * BM + wr * 64 + fr, col0 = u.pn * BM + wc * 32 + 8 * fq;
#pragma unroll
        for (int ai = 0; ai < 2; ++ai)
#pragma unroll
            for (int m = 0; m < 4; ++m) { bf16_t* rowp = O + (size_t)(row0 + ai * HALF + m * 16) * ldc + col0;
#pragma unroll
                for (int bj = 0; bj < 2; ++bj) { const f32x4 v0 = acc[ai][bj][m][0], v1 = acc[ai][bj][m][1];
                    u32x4 w; w.x = cvtpk(v0[0], v0[1]); w.y = cvtpk(v0[2], v0[3]); w.z = cvtpk(v1[0], v1[1]); w.w = cvtpk(v1[2], v1[3]);
                    *(u32x4*)(rowp + bj * HALF) = w; } }
    }
};
struct EpiRelu2 {
    static constexpr bool PERM = true, AFTER_DRAIN = false;
    bf16_t* O; int ldc;
    __device__ __forceinline__ void operator()(const f32x4 (&acc)[2][2][4][2], const Unit& u, int wr, int wc, int fr, int fq) const {
        const int row0 = u.pm * BM + wr * 64 + fr, col0 = u.pn * BM + wc * 32 + 8 * fq;
#pragma unroll
        for (int ai = 0; ai < 2; ++ai)
#pragma unroll
            for (int m = 0; m < 4; ++m) { bf16_t* rowp = O + (size_t)(row0 + ai * HALF + m * 16) * ldc + col0;
#pragma unroll
                for (int bj = 0; bj < 2; ++bj) { f32x4 v0 = acc[ai][bj][m][0], v1 = acc[ai][bj][m][1];
#pragma unroll
                    for (int i = 0; i < 4; ++i) { const float a = fmaxf(v0[i], 0.f), b = fmaxf(v1[i], 0.f); v0[i] = a * a; v1[i] = b * b; }
                    u32x4 w; w.x = cvtpk(v0[0], v0[1]); w.y = cvtpk(v0[2], v0[3]); w.z = cvtpk(v1[0], v1[1]); w.w = cvtpk(v1[2], v1[3]);
                    *(u32x4*)(rowp + bj * HALF) = w; } }
    }
};

template <class Epi, class Sched, bool ALIGN_EPI = false, bool SP2 = false>
__device__ __forceinline__ void gemm_phase(PG8_LAS unsigned char* lds, const Gemm g, const Sched& S, const Epi& E) {
    const int tid = fresh_tid(), wid = __builtin_amdgcn_readfirstlane(tid >> 6), lane = tid & 63, wr = wid >> 2, wc = wid & 3, fr = lane & 15, fq = lane >> 4;
    const int K = g.K, nt = K / BK;
    unsigned voffA[2], voffB[2];
#pragma unroll
    for (int i = 0; i < 2; ++i) { int R, C; stage_rc(tid * 16 + i * 8192, R, C); const int Rb = Epi::PERM ? ((R & ~31) + perm32(R & 31)) : R;
        voffA[i] = (unsigned)(R * K + C) * 2u; voffB[i] = (unsigned)(Rb * K + C) * 2u; }
    const size_t kstep = (size_t)(BK * 2);
    const size_t hstep = (size_t)HALF * K * 2;
    const size_t tstep = 2 * hstep;
    const unsigned ldsw = (unsigned)wid * 1024u;
    const int aoff = lds_byte(wr * 64 + fr, fq * 8), boff = lds_byte(wc * 32 + fr, fq * 8);
#define PG8_SA(b, h) (((b) * 2 + (h)) * HTB)
#define PG8_SB(b, h) ((4 + (b) * 2 + (h)) * HTB)
#define PG8_STAGE(bufoff, gbase, voff) do { _Pragma("unroll") for (int _i = 0; _i < 2; ++_i) \
        __builtin_amdgcn_global_load_lds((const unsigned*)((const char*)(gbase) + (voff)[_i]), (PG8_LAS unsigned*)(lds + (bufoff) + ldsw + _i * 8192), 16, 0, 0); } while (0)
#define PG8_LDA(dst, b, h) do { _Pragma("unroll") for (int m = 0; m < 4; ++m) _Pragma("unroll") for (int k = 0; k < 2; ++k) dst[m][k] = *(const PG8_LAS bf16x8*)(lds + PG8_SA(b, h) + aoff + m * 2048 + k * 1024); } while (0)
#define PG8_LDB(dst, b, h) do { _Pragma("unroll") for (int n = 0; n < 2; ++n) _Pragma("unroll") for (int k = 0; k < 2; ++k) dst[n][k] = *(const PG8_LAS bf16x8*)(lds + PG8_SB(b, h) + boff + n * 2048 + k * 1024); } while (0)
#define PG8_MMA(ai, bj, At, Bt) do { __builtin_amdgcn_s_setprio(1); _Pragma("unroll") for (int m = 0; m < 4; ++m) _Pragma("unroll") for (int n = 0; n < 2; ++n) _Pragma("unroll") for (int k = 0; k < 2; ++k) \
        acc[ai][bj][m][n] = __builtin_amdgcn_mfma_f32_16x16x32_bf16(Bt[n][k], At[m][k], acc[ai][bj][m][n], 0, 0, 0); __builtin_amdgcn_s_setprio(0); } while (0)
#define PG8_WAIT_V(n) asm volatile("s_waitcnt vmcnt(" #n ")" ::: "memory")
#define PG8_WAIT_L(n) asm volatile("s_waitcnt lgkmcnt(" #n ")" ::: "memory")
#define PG8_BAR __builtin_amdgcn_s_barrier()
#define PG8_SCHED __builtin_amdgcn_sched_barrier(0)
    Unit cur, nxt; int ui = 0;
    if (!S.next(0, cur)) return;
    f32x4 acc[2][2][4][2];
#pragma unroll
    for (int a = 0; a < 2; ++a)
#pragma unroll
        for (int b = 0; b < 2; ++b)
#pragma unroll
            for (int m = 0; m < 4; ++m)
#pragma unroll
                for (int n = 0; n < 2; ++n) acc[a][b][m][n] = (f32x4){0.f, 0.f, 0.f, 0.f};
    bf16x8 At[4][2], B0[2][2], B1[2][2];
    const char* cA = (const char*)g.A + (size_t)cur.pm * tstep; const char* cB = (const char*)g.Bt + (size_t)cur.pn * tstep;
    S.a_ready(cur);
    if constexpr (SP2) {
        PG8_STAGE(PG8_SB(0, 0), cB, voffB); PG8_STAGE(PG8_SB(0, 1), cB + hstep, voffB); PG8_STAGE(PG8_SA(0, 0), cA, voffA); PG8_STAGE(PG8_SA(0, 1), cA + hstep, voffA);
        if (wr == 1) PG8_BAR;
        PG8_WAIT_V(2); PG8_BAR;
        PG8_STAGE(PG8_SB(1, 0), cB + kstep, voffB); PG8_STAGE(PG8_SA(1, 0), cA + kstep, voffA); PG8_STAGE(PG8_SB(1, 1), cB + hstep + kstep, voffB);
        PG8_WAIT_V(6); PG8_BAR;
    } else {
        PG8_STAGE(PG8_SB(0, 0), cB, voffB); PG8_STAGE(PG8_SA(0, 0), cA, voffA); PG8_STAGE(PG8_SB(0, 1), cB + hstep, voffB); PG8_STAGE(PG8_SA(0, 1), cA + hstep, voffA);
        if (wr == 1) PG8_BAR;
        PG8_WAIT_V(4); PG8_BAR;
        PG8_STAGE(PG8_SB(1, 0), cB + kstep, voffB); PG8_STAGE(PG8_SA(1, 0), cA + kstep, voffA); PG8_STAGE(PG8_SB(1, 1), cB + hstep + kstep, voffB);
        PG8_WAIT_V(6); PG8_BAR;
    }
    for (;;) {
        const bool has_next = S.next(ui + 1, nxt);
        const char* nA = has_next ? (const char*)g.A + (size_t)nxt.pm * tstep : cA; const char* nB = has_next ? (const char*)g.Bt + (size_t)nxt.pn * tstep : cB;
        for (int t = 0; t < nt; t += 2) {
            const bool last = (t == nt - 2);
            const char* a1 = cA + (size_t)(t + 1) * kstep;
            const char* a2 = last ? nA : cA + (size_t)(t + 2) * kstep; const char* b2 = last ? nB : cB + (size_t)(t + 2) * kstep;
            const char* a3 = a2 + kstep; const char* b3 = b2 + kstep;
            if (last && has_next) S.a_ready(nxt);
            if constexpr (SP2) {
            PG8_LDB(B0, 0, 0); PG8_LDB(B1, 0, 1); PG8_SCHED; PG8_LDA(At, 0, 0); PG8_STAGE(PG8_SA(1, 1), a1 + hstep, voffA);
            PG8_WAIT_V(8); PG8_WAIT_L(0); PG8_BAR; PG8_MMA(0, 0, At, B0); PG8_MMA(0, 1, At, B1); PG8_BAR; PG8_SCHED;
            PG8_LDA(At, 0, 1); PG8_STAGE(PG8_SB(0, 0), b2, voffB); PG8_STAGE(PG8_SB(0, 1), b2 + hstep, voffB); PG8_STAGE(PG8_SA(0, 0), a2, voffA);
            PG8_WAIT_V(8); PG8_WAIT_L(0); PG8_BAR; PG8_MMA(1, 0, At, B0); PG8_MMA(1, 1, At, B1); PG8_BAR; PG8_SCHED;
            PG8_LDB(B0, 1, 0); PG8_LDB(B1, 1, 1); PG8_SCHED; PG8_LDA(At, 1, 0); PG8_STAGE(PG8_SA(0, 1), a2 + hstep, voffA);
            PG8_WAIT_V(8); PG8_WAIT_L(0); PG8_BAR; PG8_MMA(0, 0, At, B0); PG8_MMA(0, 1, At, B1); PG8_BAR; PG8_SCHED;
            PG8_LDA(At, 1, 1); PG8_STAGE(PG8_SB(1, 0), b3, voffB); PG8_STAGE(PG8_SB(1, 1), b3 + hstep, voffB); PG8_STAGE(PG8_SA(1, 0), a3, voffA);
            PG8_WAIT_V(8); PG8_WAIT_L(0); PG8_BAR; PG8_MMA(1, 0, At, B0); PG8_MMA(1, 1, At, B1); PG8_BAR; PG8_SCHED;
            } else {
            PG8_LDB(B0, 0, 0); PG8_SCHED; PG8_LDA(At, 0, 0); PG8_STAGE(PG8_SA(1, 1), a1 + hstep, voffA);
            PG8_WAIT_L(8); PG8_BAR; PG8_WAIT_L(0); PG8_MMA(0, 0, At, B0); PG8_BAR; PG8_SCHED;
            PG8_LDB(B1, 0, 1); PG8_STAGE(PG8_SB(0, 0), b2, voffB);
            PG8_BAR; PG8_WAIT_L(0); PG8_MMA(0, 1, At, B1); PG8_BAR;
            PG8_LDA(At, 0, 1); PG8_STAGE(PG8_SA(0, 0), a2, voffA);
            PG8_BAR; PG8_WAIT_L(0); PG8_MMA(1, 0, At, B0); PG8_BAR; PG8_SCHED;
            PG8_STAGE(PG8_SB(0, 1), b2 + hstep, voffB);
            PG8_WAIT_V(6); PG8_BAR; PG8_MMA(1, 1, At, B1); PG8_BAR;
            PG8_LDB(B0, 1, 0); PG8_SCHED; PG8_LDA(At, 1, 0); PG8_STAGE(PG8_SA(0, 1), a2 + hstep, voffA);
            PG8_WAIT_L(8); PG8_BAR; PG8_WAIT_L(0); PG8_MMA(0, 0, At, B0); PG8_BAR; PG8_SCHED;
            PG8_LDB(B1, 1, 1); PG8_STAGE(PG8_SB(1, 0), b3, voffB);
            PG8_BAR; PG8_WAIT_L(0); PG8_MMA(0, 1, At, B1); PG8_BAR;
            PG8_LDA(At, 1, 1); PG8_STAGE(PG8_SA(1, 0), a3, voffA);
            PG8_BAR; PG8_WAIT_L(0); PG8_MMA(1, 0, At, B0); PG8_BAR; PG8_SCHED;
            PG8_STAGE(PG8_SB(1, 1), b3 + hstep, voffB);
            PG8_WAIT_V(6); PG8_BAR; PG8_MMA(1, 1, At, B1); PG8_BAR;
            }
        }
        if constexpr (ALIGN_EPI) { if (wr == 0) PG8_BAR; }
        if constexpr (!Epi::AFTER_DRAIN) { E(acc, cur, wr, wc, fr, fq); S.done(cur); }
        if (!has_next) break;
#pragma unroll
        for (int a = 0; a < 2; ++a)
#pragma unroll
            for (int b = 0; b < 2; ++b)
#pragma unroll
                for (int m = 0; m < 4; ++m)
#pragma unroll
                    for (int n = 0; n < 2; ++n) acc[a][b][m][n] = (f32x4){0.f, 0.f, 0.f, 0.f};
        cur = nxt; cA = nA; cB = nB; ++ui;
        if constexpr (ALIGN_EPI) { if (wr == 1) PG8_BAR; }
    }
    PG8_WAIT_V(0);
    if constexpr (!ALIGN_EPI) { if (wr == 0) PG8_BAR; }
    PG8_BAR;
    if constexpr (Epi::AFTER_DRAIN) { E.fused(acc, cur, wr, wc, fr, fq, lds, wid, lane); S.done(cur); }
#undef PG8_SA
#undef PG8_SB
#undef PG8_STAGE
#undef PG8_LDA
#undef PG8_LDB
#undef PG8_MMA
#undef PG8_WAIT_V
#undef PG8_WAIT_L
#undef PG8_BAR
#undef PG8_SCHED
}
}
#define XB_TMO      128
#define XB_XCNT(j)  (256  + 64 * (j))
#define XB_XSUB(j)  (1280 + 64 * (j))
#define XB_XGEN(j)  (2304 + 64 * (j))
#define XB_TOP      3328
#define XB_TOPGEN   3392
#define XCD_BAR_WORDS 3456
#define XB_SPIN_CAP (1u << 18)

__device__ __forceinline__ unsigned xb_ld(unsigned* p)              { return __hip_atomic_load(p, __ATOMIC_RELAXED, __HIP_MEMORY_SCOPE_AGENT); }
__device__ __forceinline__ unsigned xb_add(unsigned* p, unsigned v) { return __hip_atomic_fetch_add(p, v, __ATOMIC_RELAXED, __HIP_MEMORY_SCOPE_AGENT); }
__device__ __forceinline__ unsigned xb_xcc_id() { return (unsigned)__builtin_amdgcn_s_getreg((3 << 11) | 20) & 0xFu; }
#define XB_SPIN(cond, bar) do { unsigned _sp = 0; while (cond) { __builtin_amdgcn_s_sleep(1); \
    if ((++_sp & 255u) == 0u) { if (xb_ld(&(bar)[XB_TMO])) break; if (_sp > XB_SPIN_CAP) { atomicAdd(&(bar)[XB_TMO], 1u); break; } } } } while (0)

struct XcdBarrier {
    unsigned* bar; unsigned x;
    volatile LAS unsigned* st;
};

__device__ __forceinline__ XcdBarrier xcd_barrier_post(unsigned* bar, volatile LAS unsigned* st) {
    XcdBarrier b; b.bar = bar; b.x = xb_xcc_id(); b.st = st;
    if (threadIdx.x == 0) (void)xb_add(&bar[XB_XCNT(b.x)], 1u);
    return b;
}
__device__ __forceinline__ void xcd_barrier_complete(unsigned* bar, unsigned x, unsigned& nloc, unsigned& nx) {
    const unsigned G = gridDim.x * gridDim.y * gridDim.z;
    unsigned sum, cnt, mine, sp = 0u;
    for (;;) {
        sum = 0u; cnt = 0u; mine = 0u;
#pragma unroll
        for (unsigned j = 0; j < 16; ++j) { const unsigned c = xb_ld(&bar[XB_XCNT(j)]); sum += c; cnt += (c > 0u) ? 1u : 0u; mine = (j == x) ? c : mine; }
        if (sum == G) break;
        __builtin_amdgcn_s_sleep(1);
        if ((++sp & 255u) == 0u) { if (xb_ld(&bar[XB_TMO])) break; if (sp > XB_SPIN_CAP) { atomicAdd(&bar[XB_TMO], 1u); break; } }
    }
    nloc = mine > 0u ? mine : 1u; nx = cnt > 0u ? cnt : 1u;
}

__device__ __forceinline__ void xcd_barrier(const XcdBarrier& b) {
    asm volatile("s_waitcnt vmcnt(0)" ::: "memory");
    __syncthreads();
    if (threadIdx.x == 0) {
        unsigned* bar = b.bar;
        __builtin_amdgcn_s_waitcnt(0);
        unsigned nloc = b.st[0], nx = b.st[1];
        if (nloc == 0u) { xcd_barrier_complete(bar, b.x, nloc, nx); b.st[0] = nloc; b.st[1] = nx; }
        const unsigned old = xb_add(&bar[XB_XSUB(b.x)], 1u);
        const unsigned gen = old / nloc;
        if (old + 1u == (gen + 1u) * nloc) {
            __builtin_amdgcn_fence(__ATOMIC_RELEASE, "agent");
            asm volatile("s_waitcnt vmcnt(0)" ::: "memory");
            const unsigned og = xb_add(&bar[XB_TOP], 1u);
            const unsigned tg = og / nx;
            if (og + 1u == (tg + 1u) * nx) xb_add(&bar[XB_TOPGEN], 1u);
            else XB_SPIN(xb_ld(&bar[XB_TOPGEN]) == tg, bar);
            __builtin_amdgcn_fence(__ATOMIC_ACQUIRE, "agent");
            xb_add(&bar[XB_XGEN(b.x)], 1u);
            asm volatile("s_waitcnt vmcnt(0)" ::: "memory");
        } else {
            XB_SPIN(xb_ld(&bar[XB_XGEN(b.x)]) == gen, bar);
            __builtin_amdgcn_fence(__ATOMIC_ACQUIRE, "agent");
            asm volatile("s_waitcnt vmcnt(0)" ::: "memory");
        }
    }
    __syncthreads();
}

typedef unsigned short bf16_t;
typedef short bf16x8 __attribute__((ext_vector_type(8)));
typedef float f32x4 __attribute__((ext_vector_type(4)));
typedef float f32x16 __attribute__((ext_vector_type(16)));
typedef unsigned u32x4 __attribute__((ext_vector_type(4)));
typedef unsigned u32x2 __attribute__((ext_vector_type(2)));
using pg8::cvtpk;
#define MFMA32(a, b, c) __builtin_amdgcn_mfma_f32_32x32x16_bf16((a), (b), (c), 0, 0, 0)
__device__ __forceinline__ float wave_sum(float v) {
#pragma unroll
    for (int o = 1; o < 64; o <<= 1) v += __shfl_xor(v, o);
    return v;
}
__device__ __forceinline__ float ex2(float x) { return __builtin_amdgcn_exp2f(x); }
__device__ __forceinline__ float lg2(float x) { return __builtin_amdgcn_logf(x); }

constexpr size_t MiB = 1u << 20;
constexpr size_t WS_ROPE = 1 * MiB;
constexpr size_t WS_WI = 2 * MiB, WS_WO = 8 * MiB, WS_WU = 10 * MiB, WS_WD = 18 * MiB;
constexpr size_t WS_HN = 26 * MiB;
constexpr size_t WS_Y = 58 * MiB;
constexpr size_t WS_QK = 58 * MiB;
constexpr size_t WS_U = 122 * MiB;
constexpr size_t WS_VTA = 122 * MiB, WS_VTB = 138 * MiB, WS_VTC = 146 * MiB;
constexpr size_t WS_OA = 154 * MiB;
constexpr size_t WS_CAT = 218 * MiB;
constexpr size_t WS_END = 250 * MiB;
static_assert(WS_VTB - WS_VTA == VTB_OFF * 2 && WS_VTC - WS_VTA == VTC_OFF * 2, "V^T offsets");

namespace att {
constexpr int KROW = 144;
constexpr int KBUF = 64 * KROW, VBUF = 128 * KROW;
constexpr int L_K0 = 0, L_K1 = KBUF, L_V0 = 2 * KBUF, L_V1 = 2 * KBUF + VBUF, L_MISC = 2 * KBUF + 2 * VBUF;
constexpr int L_RB = L_MISC, L_FLAG = L_MISC + 2048;

template <int DV> struct TileRegs { u32x4 k; u32x4 v[DV / 64]; };
template <int DV> __device__ __forceinline__ void tile_load(TileRegs<DV>& r, const bf16_t* Kb, const bf16_t* Vb, int key0, int tid) {
    const int row = tid >> 3, ch = tid & 7;
    r.k = *(const u32x4*)(Kb + (size_t)(key0 + row) * QKP + ch * 8);
#pragma unroll
    for (int i = 0; i < DV / 64; ++i) r.v[i] = *(const u32x4*)(Vb + (size_t)(row + 64 * i) * SEQ + key0 + ch * 8);
}
template <int DV> __device__ __forceinline__ void tile_store(const TileRegs<DV>& r, LAS unsigned char* lds, int kbuf, int vbuf, int tid) {
    const int row = tid >> 3, ch = tid & 7;
    *(LAS u32x4*)(lds + kbuf + row * KROW + ch * 16) = r.k;
#pragma unroll
    for (int i = 0; i < DV / 64; ++i) *(LAS u32x4*)(lds + vbuf + (row + 64 * i) * KROW + ch * 16) = r.v[i];
}
__device__ __forceinline__ void qk_tile(f32x16& s0, f32x16& s1, LAS const unsigned char* kp, const bf16x8 (&q)[4]) {
#pragma unroll
    for (int i = 0; i < 16; ++i) { s0[i] = 0.f; s1[i] = 0.f; }
    bf16x8 a0[4], a1[4];
#pragma unroll
    for (int d0 = 0; d0 < 4; ++d0) { a0[d0] = *(LAS const bf16x8*)(kp + d0 * 32); a1[d0] = *(LAS const bf16x8*)(kp + 32 * KROW + d0 * 32); }
#pragma unroll
    for (int d0 = 0; d0 < 4; ++d0) { s0 = MFMA32(a0[d0], q[d0], s0); s1 = MFMA32(a1[d0], q[d0], s1); }
}
__device__ __forceinline__ bf16x8 pack8(const f32x16& s, int b) {
    u32x4 w; w.x = cvtpk(s[b], s[b + 1]); w.y = cvtpk(s[b + 2], s[b + 3]); w.z = cvtpk(s[b + 4], s[b + 5]); w.w = cvtpk(s[b + 6], s[b + 7]);
    return __builtin_bit_cast(bf16x8, w);
}
template <int NDB> __device__ __forceinline__ void pv_tile(f32x16 (&o)[NDB], LAS const unsigned char* vp, const bf16x8 (&pf)[4]) {
#pragma unroll
    for (int dp = 0; dp < NDB; dp += 2) {
        bf16x8 a[8];
#pragma unroll
        for (int i = 0; i < 8; ++i) a[i] = *(LAS const bf16x8*)(vp + (dp + (i >> 2)) * 32 * KROW + (i & 3) * 32);
#pragma unroll
        for (int kg = 0; kg < 4; ++kg) { o[dp] = MFMA32(a[kg], pf[kg], o[dp]); o[dp + 1] = MFMA32(a[4 + kg], pf[kg], o[dp + 1]); }
    }
}
template <int NDB> __device__ __forceinline__ void softmax_update(f32x16& s0, f32x16& s1, float& m, float& l, f32x16 (&o)[NDB], LAS const unsigned char* vp) {
    float mx = fmaxf(s0[0], s1[0]);
#pragma unroll
    for (int i = 1; i < 16; ++i) mx = fmaxf(mx, fmaxf(s0[i], s1[i]));
    mx = fmaxf(mx, __shfl_xor(mx, 32));
    const float mn = fmaxf(m, mx), alpha = ex2(m - mn); m = mn;
    float ps = 0.f;
#pragma unroll
    for (int i = 0; i < 16; ++i) { s0[i] = ex2(s0[i] - mn); s1[i] = ex2(s1[i] - mn); ps += s0[i] + s1[i]; }
    l = l * alpha + ps;
#pragma unroll
    for (int db = 0; db < NDB; ++db) o[db] = o[db] * alpha;
    bf16x8 pf[4]; pf[0] = pack8(s0, 0); pf[1] = pack8(s0, 8); pf[2] = pack8(s1, 0); pf[3] = pack8(s1, 8);
    pv_tile<NDB>(o, vp, pf);
}
struct Lane { int tid, wid, lane, rho, hi, koff, voff; };
__device__ __forceinline__ Lane make_lane() {
    Lane L; L.tid = fresh_tid(); L.wid = __builtin_amdgcn_readfirstlane(L.tid >> 6); L.lane = L.tid & 63; L.rho = L.lane & 31; L.hi = L.lane >> 5;
    const int pr = (L.rho & ~12) | ((L.rho & 4) << 1) | ((L.rho & 8) >> 1);
    L.koff = pr * KROW + L.hi * 16; L.voff = L.rho * KROW + L.hi * 16; return L;
}
__device__ __forceinline__ void load_q(bf16x8 (&q)[4], const bf16_t* Qrow  ) {
#pragma unroll
    for (int d0 = 0; d0 < 4; ++d0) q[d0] = *(const bf16x8*)(Qrow + d0 * 16);
}

constexpr int STG_A = KBUF + VBUF;
__device__ __forceinline__ void qk_tile_ref(f32x16& s0, f32x16& s1, LAS const unsigned char* kp, const bf16x8 (&q)[4], float negm) {
#pragma unroll
    for (int i = 0; i < 16; ++i) { s0[i] = negm; s1[i] = negm; }
    bf16x8 a0[4], a1[4];
#pragma unroll
    for (int d0 = 0; d0 < 4; ++d0) { a0[d0] = *(LAS const bf16x8*)(kp + d0 * 32); a1[d0] = *(LAS const bf16x8*)(kp + 32 * KROW + d0 * 32); }
#pragma unroll
    for (int d0 = 0; d0 < 4; ++d0) { s0 = MFMA32(a0[d0], q[d0], s0); s1 = MFMA32(a1[d0], q[d0], s1); }
}
template <int NDB, bool HAS_NEXT> __device__ __forceinline__ void sm_tile(f32x16& s0, f32x16& s1, f32x16& n0, f32x16& n1, bool first, float& m, float& l, f32x16 (&o)[NDB], LAS const unsigned char* vp) {
    float mx = fmaxf(s0[0], s1[0]);
#pragma unroll
    for (int i = 1; i < 16; ++i) mx = fmaxf(mx, fmaxf(s0[i], s1[i]));
    mx = fmaxf(mx, __shfl_xor(mx, 32));
    if (first || __any(mx > 8.0f)) {
        const float dl = first ? mx : fmaxf(mx, 0.f);
        m += dl; s0 = s0 - dl; s1 = s1 - dl;
        if (HAS_NEXT) { n0 = n0 - dl; n1 = n1 - dl; }
        if (!first) { const float alpha = ex2(-dl); l *= alpha;
#pragma unroll
            for (int db = 0; db < NDB; ++db) o[db] = o[db] * alpha; }
    }
    float ps = 0.f;
#pragma unroll
    for (int i = 0; i < 16; ++i) { s0[i] = ex2(s0[i]); s1[i] = ex2(s1[i]); }
#pragma unroll
    for (int i = 0; i < 16; ++i) ps += s0[i] + s1[i];
    l += ps;
    bf16x8 pf[4]; pf[0] = pack8(s0, 0); pf[1] = pack8(s0, 8); pf[2] = pack8(s1, 0); pf[3] = pack8(s1, 8);
    pv_tile<NDB>(o, vp, pf);
}
__device__ __forceinline__ void qk_blk(f32x16& s, LAS const unsigned char* kp, const bf16x8 (&q)[4], float negm) {
#pragma unroll
    for (int i = 0; i < 16; ++i) s[i] = negm;
    bf16x8 a[4];
#pragma unroll
    for (int d0 = 0; d0 < 4; ++d0) a[d0] = *(LAS const bf16x8*)(kp + d0 * 32);
#pragma unroll
    for (int d0 = 0; d0 < 4; ++d0) s = MFMA32(a[d0], q[d0], s);
}
template <int NDB, bool HAS_NEXT> __device__ __forceinline__ void sm_blk(f32x16& s, f32x16& n, bool first, float& m, float& l, f32x16 (&o)[NDB], LAS const unsigned char* vp) {
    float mx = fmaxf(s[0], s[1]);
#pragma unroll
    for (int i = 2; i < 16; ++i) mx = fmaxf(mx, s[i]);
    mx = fmaxf(mx, __shfl_xor(mx, 32));
    if (first || __any(mx > 8.0f)) {
        const float dl = first ? mx : fmaxf(mx, 0.f);
        m += dl; s = s - dl;
        if (HAS_NEXT) n = n - dl;
        if (!first) { const float alpha = ex2(-dl); l *= alpha;
#pragma unroll
            for (int db = 0; db < NDB; ++db) o[db] = o[db] * alpha; }
    }
#pragma unroll
    for (int i = 0; i < 16; ++i) s[i] = ex2(s[i]);
    float ps = 0.f;
#pragma unroll
    for (int i = 0; i < 16; ++i) ps += s[i];
    l += ps;
    const bf16x8 pf0 = pack8(s, 0), pf1 = pack8(s, 8);
    bf16x8 a[2 * NDB];
#pragma unroll
    for (int db = 0; db < NDB; ++db) { a[2 * db] = *(LAS const bf16x8*)(vp + db * 32 * KROW); a[2 * db + 1] = *(LAS const bf16x8*)(vp + db * 32 * KROW + 32); }
#pragma unroll
    for (int db = 0; db < NDB; ++db) o[db] = MFMA32(a[2 * db], pf0, o[db]);
#pragma unroll
    for (int db = 0; db < NDB; ++db) o[db] = MFMA32(a[2 * db + 1], pf1, o[db]);
}
__device__ __forceinline__ void attnA_item(LAS unsigned char* lds, const Lane& L, const bf16_t* QK, const bf16_t* VTa, float* OA, int b, int h, int n, int qblk) {
    const int rowq = qblk * 256 + L.wid * 32, cw = rowq >> 6;
    const size_t tok0 = (size_t)b * SEQ;
    bf16x8 q[4]; load_q(q, QK + (tok0 + rowq + L.rho) * QKP + h * 128 + n * 64 + L.hi * 8);
    const bf16_t* Kb = QK + tok0 * QKP + 512 + h * 128 + n * 64;
    const bf16_t* Vb = VTa + (size_t)((b * 4 + h) * 128) * SEQ;
    const int NT = 4 * qblk + 4;
    TileRegs<128> tr;
    tile_load<128>(tr, Kb, Vb, 0, L.tid); tile_store<128>(tr, lds, 0, KBUF, L.tid); __syncthreads();
    float m = 0.f, l = 0.f; f32x16 o[4];
#pragma unroll
    for (int db = 0; db < 4; ++db)
#pragma unroll
        for (int i = 0; i < 16; ++i) o[db][i] = 0.f;
    int sc = 0, sn = STG_A;
    for (int t = 0; t < NT; ++t) {
        if (t + 1 < NT) tile_load<128>(tr, Kb, Vb, (t + 1) * 64, L.tid);
        if (t <= cw) {
            LAS const unsigned char* vp = lds + sc + KBUF + L.voff;
            f32x16 c0, c1; qk_tile_ref(c0, c1, lds + sc + L.koff, q, -m);
            sm_blk<4, true>(c0, c1, t == 0, m, l, o, vp);
            sm_blk<4, false>(c1, c1, false, m, l, o, vp + 64);
        }
        if (t + 1 < NT) tile_store<128>(tr, lds, sn, sn + KBUF, L.tid);
        __syncthreads();
        const int tmp = sc; sc = sn; sn = tmp;
    }
    l += __shfl_xor(l, 32);
    const float inv = 1.0f / l;
    float* op = OA + ((size_t)n * NTOK + tok0 + rowq + L.rho) * 512 + h * 128 + 4 * L.hi;
#pragma unroll
    for (int db = 0; db < 4; ++db)
#pragma unroll
        for (int g = 0; g < 4; ++g) { f32x4 v = {o[db][4 * g], o[db][4 * g + 1], o[db][4 * g + 2], o[db][4 * g + 3]}; *(f32x4*)(op + db * 32 + 8 * g) = v * inv; }
}
__device__ __forceinline__ void store_head_norm(const f32x16 (&o)[2], const Lane& L, const float* gain  , bf16_t* dst  ) {
    float ss = 0.f;
#pragma unroll
    for (int db = 0; db < 2; ++db)
#pragma unroll
        for (int i = 0; i < 16; ++i) ss += o[db][i] * o[db][i];
    ss += __shfl_xor(ss, 32);
    const float rs = rsqrtf(ss * (1.0f / 64.0f) + RMS_EPS);
#pragma unroll
    for (int db = 0; db < 2; ++db)
#pragma unroll
        for (int g = 0; g < 4; ++g) { const int d = db * 32 + 8 * g + 4 * L.hi; const f32x4 gv = *(const f32x4*)(gain + d);
            u32x2 w; w.x = cvtpk(o[db][4 * g] * rs * gv[0], o[db][4 * g + 1] * rs * gv[1]); w.y = cvtpk(o[db][4 * g + 2] * rs * gv[2], o[db][4 * g + 3] * rs * gv[3]);
            *(u32x2*)(dst + d) = w; }
}
__device__ __forceinline__ void attnB_item(LAS unsigned char* lds, const Lane& L, const bf16_t* QK, const bf16_t* VTb, bf16_t* CAT, const float* relb  , const float* gnb, int b, int h, int qblk) {
    const int rowq = qblk * 256 + L.wid * 32, cw = rowq >> 6;
    const size_t tok0 = (size_t)b * SEQ;
    LAS float* rb = (LAS float*)(lds + L_RB);
    if (L.tid < 257) rb[L.tid] = relb[h * 257 + L.tid] * LOG2E;
    bf16x8 q[4]; load_q(q, QK + (tok0 + rowq + L.rho) * QKP + 1024 + h * 64 + L.hi * 8);
    const bf16_t* Kb = QK + tok0 * QKP + 1280 + h * 64;
    const bf16_t* Vb = VTb + (size_t)((b * 4 + h) * 64) * SEQ;
    const int t_lo = (4 * qblk - 8) > 0 ? (4 * qblk - 8) : 0, t_hi = 4 * qblk + 3;
    TileRegs<64> tr;
    tile_load<64>(tr, Kb, Vb, t_lo * 64, L.tid); tile_store<64>(tr, lds, L_K0, L_V0, L.tid); __syncthreads();
    float m = -1e30f, l = 0.f; f32x16 o[2];
#pragma unroll
    for (int db = 0; db < 2; ++db)
#pragma unroll
        for (int i = 0; i < 16; ++i) o[db][i] = 0.f;
    const int qpos = rowq + L.rho;
    for (int t = t_lo; t <= t_hi; ++t) {
        const int cur = (t - t_lo) & 1;
        if (t < t_hi) tile_load<64>(tr, Kb, Vb, (t + 1) * 64, L.tid);
        if (t <= cw && t >= cw - 8) {
            f32x16 s0, s1; qk_tile(s0, s1, lds + (cur ? L_K1 : L_K0) + L.koff, q);
            if (cw - t >= 3) {
                const float bc = rb[256];
#pragma unroll
                for (int i = 0; i < 16; ++i) { s0[i] += bc; s1[i] += bc; }
            } else {
                const int rel0 = qpos - (t * 64 + 8 * L.hi);
#pragma unroll
                for (int r = 0; r < 16; ++r) { const int ko = 16 * (r >> 3) + (r & 7);
                    int i0 = rel0 - ko; i0 = (i0 > 128 ? 128 : i0) + 128; int i1 = rel0 - 32 - ko; i1 = (i1 > 128 ? 128 : i1) + 128;
                    s0[r] += rb[i0]; s1[r] += rb[i1]; }
            }
            softmax_update<2>(s0, s1, m, l, o, lds + (cur ? L_V1 : L_V0) + L.voff);
        }
        if (t < t_hi) tile_store<64>(tr, lds, cur ? L_K0 : L_K1, cur ? L_V0 : L_V1, L.tid);
        __syncthreads();
    }
    l += __shfl_xor(l, 32);
    const float inv = 1.0f / l;
#pragma unroll
    for (int db = 0; db < 2; ++db) o[db] = o[db] * inv;
    store_head_norm(o, L, gnb + h * 64, CAT + (tok0 + rowq + L.rho) * 1024 + 512 + h * 64);
}
__device__ __forceinline__ void stick_block(const f32x16& y, int kbase, int lim, int hi, float& R, bf16x8& pf0, bf16x8& pf1) {
    f32x16 ls, lb;
#pragma unroll
    for (int r = 0; r < 16; ++r) {
        const int kpos = kbase + 16 * (r >> 3) + 8 * hi + (r & 7);
        const float yy = y[r], sp = fmaxf(yy, 0.f) + lg2(1.0f + ex2(-fabsf(yy)));
        const bool valid = kpos < lim;
        ls[r] = valid ? -sp : 0.f;
        lb[r] = valid ? (yy - sp) : -1e30f;
    }
    float g0 = 0.f, g1 = 0.f;
#pragma unroll
    for (int i = 0; i < 8; ++i) { g0 += ls[i]; g1 += ls[8 + i]; }
    const float p0 = __shfl_xor(g0, 32), p1 = __shfl_xor(g1, 32);
    const float G11 = hi ? g1 : p1, G01 = hi ? p1 : g1, G10 = hi ? g0 : p0, G00 = hi ? p0 : g0;
    float run1 = R + (hi ? 0.f : G11);
    float run0 = R + (G11 + G01) + (hi ? 0.f : G10);
    f32x16 a;
#pragma unroll
    for (int i = 7; i >= 0; --i) {
        a[8 + i] = ex2(lb[8 + i] + run1); run1 += ls[8 + i];
        a[i] = ex2(lb[i] + run0); run0 += ls[i];
    }
    R += (G11 + G01) + (G10 + G00);
    pf0 = pack8(a, 0); pf1 = pack8(a, 8);
}
__device__ __forceinline__ void attnC_item(LAS unsigned char* lds, const Lane& L, const bf16_t* QK, const bf16_t* VTc, bf16_t* CAT, const float* gnc, int b, int h, int qblk) {
    const int rowq = qblk * 256 + L.wid * 32, cw = rowq >> 6;
    const size_t tok0 = (size_t)b * SEQ;
    volatile LAS unsigned* flag = (volatile LAS unsigned*)(lds + L_FLAG);
    bf16x8 q[4]; load_q(q, QK + (tok0 + rowq + L.rho) * QKP + 1536 + h * 64 + L.hi * 8);
    const bf16_t* Kb = QK + tok0 * QKP + 1792 + h * 64;
    const bf16_t* Vb = VTc + (size_t)((b * 4 + h) * 64) * SEQ;
    const int t_hi = 4 * qblk + 3;
    TileRegs<64> tr;
    tile_load<64>(tr, Kb, Vb, t_hi * 64, L.tid); tile_store<64>(tr, lds, L_K0, L_V0, L.tid); __syncthreads();
    float R = 0.f; f32x16 o[2];
#pragma unroll
    for (int db = 0; db < 2; ++db)
#pragma unroll
        for (int i = 0; i < 16; ++i) o[db][i] = 0.f;
    const int qpos = rowq + L.rho;
    bool wdone = false;
    for (int t = t_hi; t >= 0; --t) {
        const int it = t_hi - t, cur = it & 1;
        if (t > 0) tile_load<64>(tr, Kb, Vb, (t - 1) * 64, L.tid);
        if (t <= cw && !wdone) {
            f32x16 s0, s1; qk_tile(s0, s1, lds + (cur ? L_K1 : L_K0) + L.koff, q);
            const int lim = (t == cw) ? qpos : 0x7fffffff;
            bf16x8 pf[4];
            stick_block(s1, t * 64 + 32, lim, L.hi, R, pf[2], pf[3]);
            stick_block(s0, t * 64, lim, L.hi, R, pf[0], pf[1]);
            pv_tile<2>(o, lds + (cur ? L_V1 : L_V0) + L.voff, pf);
            wdone = __all(R < -150.0f) != 0;
        }
        if (L.lane == 0) flag[cur * 8 + L.wid] = (wdone || t == 0) ? 1u : 0u;
        if (t > 0) tile_store<64>(tr, lds, cur ? L_K0 : L_K1, cur ? L_V0 : L_V1, L.tid);
        __syncthreads();
        unsigned alld = 1u;
#pragma unroll
        for (int w = 0; w < 8; ++w) alld &= flag[cur * 8 + w];
        if (alld) break;
    }
    __syncthreads();
    store_head_norm(o, L, gnc + h * 64, CAT + (tok0 + rowq + L.rho) * 1024 + 768 + h * 64);
}
}

__device__ __forceinline__ void store_row_bf16(bf16_t* orow, const f32x4 (&v)[4], int lane) {
#pragma unroll
    for (int j = 0; j < 4; ++j) { u32x2 w; w.x = cvtpk(v[j][0], v[j][1]); w.y = cvtpk(v[j][2], v[j][3]); *((u32x2*)orow + lane + 64 * j) = w; }
}
__device__ __forceinline__ void prenorm_pass(const float* x, const float* g, bf16_t* HN, int gw, int NGW, int lane) {
    for (int m = gw; m < NTOK; m += NGW) {
        const f32x4* xr = (const f32x4*)(x + (size_t)m * DM) + lane; f32x4 v[4]; float s = 0.f;
#pragma unroll
        for (int j = 0; j < 4; ++j) { v[j] = xr[64 * j]; s += (v[j][0] * v[j][0] + v[j][1] * v[j][1]) + (v[j][2] * v[j][2] + v[j][3] * v[j][3]); }
        const float rs = rsqrtf(wave_sum(s) * (1.0f / DM) + RMS_EPS);
#pragma unroll
        for (int j = 0; j < 4; ++j) v[j] = v[j] * rs * ((const f32x4*)g)[lane + 64 * j];
        store_row_bf16(HN + (size_t)m * DM, v, lane);
    }
}
__device__ __forceinline__ void postnorm_pass(const bf16_t* Y, const float* xin, float* xout, const float* gpost, const float* gnext, bf16_t* HN, int gw, int NGW, int lane) {
    for (int m = gw; m < NTOK; m += NGW) {
        const u32x2* yr = (const u32x2*)(Y + (size_t)m * DM) + lane; const f32x4* xr = (const f32x4*)(xin + (size_t)m * DM) + lane;
        f32x4 y[4], v[4]; float s = 0.f;
#pragma unroll
        for (int j = 0; j < 4; ++j) { const u32x2 w = yr[64 * j]; v[j] = xr[64 * j];
            y[j][0] = __uint_as_float(w.x << 16); y[j][1] = __uint_as_float(w.x & 0xffff0000u); y[j][2] = __uint_as_float(w.y << 16); y[j][3] = __uint_as_float(w.y & 0xffff0000u);
            s += (y[j][0] * y[j][0] + y[j][1] * y[j][1]) + (y[j][2] * y[j][2] + y[j][3] * y[j][3]); }
        const float rs = rsqrtf(wave_sum(s) * (1.0f / DM) + RMS_EPS);
        float s2 = 0.f;
#pragma unroll
        for (int j = 0; j < 4; ++j) { v[j] = v[j] + y[j] * rs * ((const f32x4*)gpost)[lane + 64 * j]; s2 += (v[j][0] * v[j][0] + v[j][1] * v[j][1]) + (v[j][2] * v[j][2] + v[j][3] * v[j][3]); }
        f32x4* xo = (f32x4*)(xout + (size_t)m * DM) + lane;
#pragma unroll
        for (int j = 0; j < 4; ++j) xo[64 * j] = v[j];
        if (gnext) {
            const float rs2 = rsqrtf(wave_sum(s2) * (1.0f / DM) + RMS_EPS);
#pragma unroll
            for (int j = 0; j < 4; ++j) v[j] = v[j] * rs2 * ((const f32x4*)gnext)[lane + 64 * j];
            store_row_bf16(HN + (size_t)m * DM, v, lane);
        }
    }
}
__device__ __forceinline__ void combine_pass(const float* OA, bf16_t* CAT, const float* subln, float lam, float oscale, int gw, int NGW, int lane) {
    const int e0 = (lane & 15) * 8;
    const f32x4 g0 = *(const f32x4*)(subln + e0), g1 = *(const f32x4*)(subln + e0 + 4);
    for (int m = gw; m < NTOK; m += NGW) {
        const f32x4* a = (const f32x4*)(OA + (size_t)m * 512) + 2 * lane; const f32x4* c = (const f32x4*)(OA + ((size_t)NTOK + m) * 512) + 2 * lane;
        f32x4 d0 = a[0] - c[0] * lam, d1 = a[1] - c[1] * lam;
        float ss = (d0[0] * d0[0] + d0[1] * d0[1]) + (d0[2] * d0[2] + d0[3] * d0[3]) + (d1[0] * d1[0] + d1[1] * d1[1]) + (d1[2] * d1[2] + d1[3] * d1[3]);
#pragma unroll
        for (int o = 1; o < 16; o <<= 1) ss += __shfl_xor(ss, o);
        const float rs = rsqrtf(ss * (1.0f / 128.0f) + RMS_EPS) * oscale;
        d0 = d0 * rs * g0; d1 = d1 * rs * g1;
        u32x4 w; w.x = cvtpk(d0[0], d0[1]); w.y = cvtpk(d0[2], d0[3]); w.z = cvtpk(d1[0], d1[1]); w.w = cvtpk(d1[2], d1[3]);
        *((u32x4*)(CAT + (size_t)m * 1024) + lane) = w;
    }
}
__device__ __forceinline__ void transpose_item(const float* W, int K, int N, bf16_t* WT, LAS float* scr, int item, int lane) {
    const int nblk = N / 32, kb = item / nblk, nb = item % nblk, k0 = 64 * kb, n0 = 32 * nb;
#pragma unroll 8
    for (int i = 0; i < 32; ++i) { const int kk = 2 * i + (lane >> 5); scr[kk * 33 + (lane & 31)] = W[(size_t)(k0 + kk) * N + n0 + (lane & 31)]; }
    asm volatile("s_waitcnt lgkmcnt(0)" ::: "memory");
    const int c = lane & 7;
#pragma unroll
    for (int j = 0; j < 4; ++j) { const int n = (lane >> 3) + 8 * j; const LAS float* s = scr + (8 * c) * 33 + n;
        u32x4 o; o.x = cvtpk(s[0 * 33], s[1 * 33]); o.y = cvtpk(s[2 * 33], s[3 * 33]); o.z = cvtpk(s[4 * 33], s[5 * 33]); o.w = cvtpk(s[6 * 33], s[7 * 33]);
        *(u32x4*)(WT + (size_t)(n0 + n) * K + k0 + 8 * c) = o; }
    asm volatile("s_waitcnt lgkmcnt(0)" ::: "memory");
}

struct Args {
    const float* x; const float* g_pre_mix; const float* w_in; const float* lq1; const float* lk1; const float* lq2; const float* lk2;
    const float* subln; const float* relb; const float* gnb; const float* gnc; const float* w_out; const float* g_post_mix; const float* g_pre_mlp;
    const float* w_up; const float* w_down; const float* g_post_mlp;
    float* out; unsigned char* ws;
    float inv_freq[8]; float lam_init[2]; int ph_lo, ph_hi, coop, pad;
};
constexpr int NPHASE = 1 + 8 * NLAYER;
constexpr int LDS_BYTES = 147456;

__device__ __forceinline__ void convert_weights(const Args& a, int l, LAS unsigned char* lds, int gw, int NGW, int wave, int lane) {
    LAS float* scr = (LAS float*)(lds + wave * 16384);
    constexpr int I_IN = (DM / 64) * (DIN / 32), I_O = (DM / 64) * (DM / 32), I_U = (DM / 64) * (DFF / 32), I_D = (DFF / 64) * (DM / 32);
    constexpr int NITEMS = I_IN + I_O + I_U + I_D;
    bf16_t* Wi = (bf16_t*)(a.ws + WS_WI); bf16_t* Wo = (bf16_t*)(a.ws + WS_WO); bf16_t* Wu = (bf16_t*)(a.ws + WS_WU); bf16_t* Wd = (bf16_t*)(a.ws + WS_WD);
    for (int it = gw; it < NITEMS; it += NGW) {
        int r = it;
        if (r < I_IN) { transpose_item(a.w_in + (size_t)l * DM * DIN, DM, DIN, Wi, scr, r, lane); continue; } r -= I_IN;
        if (r < I_O) { transpose_item(a.w_out + (size_t)l * DM * DM, DM, DM, Wo, scr, r, lane); continue; } r -= I_O;
        if (r < I_U) { transpose_item(a.w_up + (size_t)l * DM * DFF, DM, DFF, Wu, scr, r, lane); continue; } r -= I_U;
        transpose_item(a.w_down + (size_t)l * DFF * DM, DFF, DM, Wd, scr, r, lane);
    }
}

__global__ void __launch_bounds__(512, 2) mk_fwd(Args a) {
    extern __shared__ __attribute__((aligned(16))) unsigned char lds_raw[];
    LAS unsigned char* lds = (LAS unsigned char*)lds_raw;
    cg::grid_group grid = cg::this_grid();
    const int G = gridDim.x, bx = blockIdx.x;
    const int vcu = (G % 8 == 0) ? (bx % 8) * (G / 8) + bx / 8 : bx;
    const int NGW = G * 8;
#define FRESH_IDS() const int tid = fresh_tid(), lane = tid & 63, wave = __builtin_amdgcn_readfirstlane(tid >> 6), gw = vcu * 8 + wave; (void)tid; (void)lane; (void)gw
    unsigned char* ws = a.ws;
    bf16_t* Wi = (bf16_t*)(ws + WS_WI); bf16_t* Wo = (bf16_t*)(ws + WS_WO); bf16_t* Wu = (bf16_t*)(ws + WS_WU); bf16_t* Wd = (bf16_t*)(ws + WS_WD);
    bf16_t* HN = (bf16_t*)(ws + WS_HN); bf16_t* Y = (bf16_t*)(ws + WS_Y); bf16_t* QK = (bf16_t*)(ws + WS_QK); bf16_t* U = (bf16_t*)(ws + WS_U);
    bf16_t* VTa = (bf16_t*)(ws + WS_VTA); bf16_t* VTb = (bf16_t*)(ws + WS_VTB); bf16_t* VTc = (bf16_t*)(ws + WS_VTC);
    float* OA = (float*)(ws + WS_OA); bf16_t* CAT = (bf16_t*)(ws + WS_CAT); float* rope = (float*)(ws + WS_ROPE);

    const int lo = a.ph_lo, hi = a.ph_hi;
    volatile LAS unsigned* bst = (volatile LAS unsigned*)(lds + LDS_BYTES - 64);
    if (threadIdx.x < 16) bst[threadIdx.x] = 0u;
    __syncthreads();
    XcdBarrier bar; bar.bar = (unsigned*)ws; bar.x = 0; bar.st = bst;
    if (a.coop) bar = xcd_barrier_post((unsigned*)ws, bst);
    if (a.pad == 0x7fffffff) grid.sync();
#define IN(p) (lo <= (p) && (p) < hi)
#define SEAM(p) do { if (IN((p) + 1) && a.coop) xcd_barrier(bar); } while (0)
    if (IN(0)) {
        FRESH_IDS();
        convert_weights(a, 0, lds, gw, NGW, wave, lane);
        for (int p = bx * 512 + tid; p < SEQ; p += G * 512) {
            f32x4 c[2], s[2];
#pragma unroll
            for (int j = 0; j < 8; ++j) {
                const float ang = (float)p * a.inv_freq[j];
                double t = (double)ang * 0.15915494309189535; t -= rint(t);
                const float tf = (float)t;
                c[j >> 2][j & 3] = __builtin_amdgcn_cosf(tf); s[j >> 2][j & 3] = __builtin_amdgcn_sinf(tf);
            }
            f32x4* o = (f32x4*)(rope + (size_t)p * 16); o[0] = c[0]; o[1] = c[1]; o[2] = s[0]; o[3] = s[1];
        }
        prenorm_pass(a.x, a.g_pre_mix, HN, gw, NGW, lane);
        SEAM(0);
    }
    for (int l = 0; l < NLAYER; ++l) {
        const int p0 = 1 + 8 * l;
        if (IN(p0)) {
            pg8::Gemm g{HN, Wi, NTOK, DIN, DM}; pg8::StaticOrder S; S.init(NTOK, DIN, G, bx);
            pg8::EpiProj E{QK, VTa, rope};
            for (int rep = 0; rep < PROBE_REP_G; ++rep) pg8::gemm_phase<pg8::EpiProj, pg8::StaticOrder, true, true>(lds, g, S, E);
            SEAM(p0);
        }
        if (IN(p0 + 1)) {
            const att::Lane L = att::make_lane();
            for (int rep = 0; rep < PROBE_REP_A; ++rep)
            for (int it = vcu; it < 256; it += G) {
                const int combo = it >> 3, s = it & 7, b = combo >> 3, h = (combo >> 1) & 3, n = combo & 1;
                for (int j = 0; j < 2; ++j) att::attnA_item(lds, L, QK, VTa, OA, b, h, n, j ? s : 15 - s);
            }
            for (int rep = 0; rep < PROBE_REP_B; ++rep)
            for (int it = vcu; it < 256; it += G) {
                const int b = it >> 6, h = (it >> 4) & 3, qblk = it & 15;
                att::attnB_item(lds, L, QK, VTb, CAT, a.relb + (size_t)l * 4 * 257, a.gnb + l * 256, b, h, qblk);
            }
            for (int rep = 0; rep < PROBE_REP_C; ++rep)
            for (int it = vcu; it < 256; it += G) {
                const int b = it >> 6, h = (it >> 4) & 3, qblk = it & 15;
                att::attnC_item(lds, L, QK, VTc, CAT, a.gnc + l * 256, b, h, qblk);
            }
            SEAM(p0 + 1);
        }
        if (IN(p0 + 2)) {
            FRESH_IDS();
            const float li = (l == 0) ? a.lam_init[0] : a.lam_init[1];
            const float s1 = wave_sum(a.lq1[l * 64 + lane] * a.lk1[l * 64 + lane]), s2 = wave_sum(a.lq2[l * 64 + lane] * a.lk2[l * 64 + lane]);
            const float lam = expf(s1) - expf(s2) + li;
            combine_pass(OA, CAT, a.subln + l * 128, lam, 1.0f - li, gw, NGW, lane);
            SEAM(p0 + 2);
        }
        if (IN(p0 + 3)) {
            pg8::Gemm g{CAT, Wo, NTOK, DM, DM}; pg8::StaticOrder S; S.init(NTOK, DM, G, bx);
            pg8::EpiY E{Y, DM};
            for (int rep = 0; rep < PROBE_REP_G; ++rep) pg8::gemm_phase<pg8::EpiY, pg8::StaticOrder, true, true>(lds, g, S, E);
            SEAM(p0 + 3);
        }
        if (IN(p0 + 4)) {
            FRESH_IDS();
#if PROBE_PASS
            postnorm_pass(Y, l == 0 ? a.x : a.out, OA, a.g_post_mix + l * DM, a.g_pre_mlp + l * DM, CAT, gw, NGW, lane);
#endif
            postnorm_pass(Y, l == 0 ? a.x : a.out, a.out, a.g_post_mix + l * DM, a.g_pre_mlp + l * DM, HN, gw, NGW, lane);
            SEAM(p0 + 4);
        }
        if (IN(p0 + 5)) {
            pg8::Gemm g{HN, Wu, NTOK, DFF, DM}; pg8::StaticOrder S; S.init(NTOK, DFF, G, bx);
            pg8::EpiRelu2 E{U, DFF};
            for (int rep = 0; rep < PROBE_REP_G; ++rep) pg8::gemm_phase<pg8::EpiRelu2, pg8::StaticOrder, true, true>(lds, g, S, E);
            SEAM(p0 + 5);
        }
        if (IN(p0 + 6)) {
            pg8::Gemm g{U, Wd, NTOK, DM, DFF}; pg8::StaticOrder S; S.init(NTOK, DM, G, bx);
            pg8::EpiY E{Y, DM};
            for (int rep = 0; rep < PROBE_REP_G; ++rep) pg8::gemm_phase<pg8::EpiY, pg8::StaticOrder, true, true>(lds, g, S, E);
            SEAM(p0 + 6);
        }
        if (IN(p0 + 7)) {
            FRESH_IDS();
#if PROBE_PASS
            postnorm_pass(Y, a.out, OA, a.g_post_mlp + l * DM, (l + 1 < NLAYER) ? a.g_pre_mix + (l + 1) * DM : nullptr, CAT, gw, NGW, lane);
#endif
            postnorm_pass(Y, a.out, a.out, a.g_post_mlp + l * DM, (l + 1 < NLAYER) ? a.g_pre_mix + (l + 1) * DM : nullptr, HN, gw, NGW, lane);
            if (l + 1 < NLAYER) convert_weights(a, l + 1, lds, gw, NGW, wave, lane);
            SEAM(p0 + 7);
        }
    }
#undef IN
#undef SEAM
}

extern "C" void kernel_launch(void* const* d_in, const int* in_sizes, int n_in, void* d_out, int out_size, void* d_ws, size_t ws_size, hipStream_t stream) {
    static int grid_blocks = 0;
    if (grid_blocks == 0) {
        if (n_in != 17 || ws_size < WS_END) { fprintf(stderr, "kernel_launch: unexpected inputs (n_in %d, ws %zu)\n", n_in, ws_size); grid_blocks = -1; return; }
        int dev = 0, cus = 0, per_cu = 0;
        hipGetDevice(&dev);
        hipDeviceGetAttribute(&cus, hipDeviceAttributeMultiprocessorCount, dev);
        if (hipFuncSetAttribute((const void*)mk_fwd, hipFuncAttributeMaxDynamicSharedMemorySize, LDS_BYTES) != hipSuccess) fprintf(stderr, "kernel_launch: hipFuncSetAttribute failed\n");
        if (hipOccupancyMaxActiveBlocksPerMultiprocessor(&per_cu, (const void*)mk_fwd, 512, LDS_BYTES) != hipSuccess || per_cu < 1) { fprintf(stderr, "kernel_launch: occupancy query gave %d\n", per_cu); per_cu = 1; }
        (void)hipGetLastError();
        grid_blocks = cus * per_cu;
        if (grid_blocks % 8 != 0 || grid_blocks > 1024) grid_blocks = cus;
    }
    if (grid_blocks < 0) return;
    if (hipMemsetAsync(d_ws, 0, 16384, stream) != hipSuccess) fprintf(stderr, "kernel_launch: hipMemsetAsync failed\n");
    Args a{};
    a.x = (const float*)d_in[0]; a.g_pre_mix = (const float*)d_in[1]; a.w_in = (const float*)d_in[2]; a.lq1 = (const float*)d_in[3]; a.lk1 = (const float*)d_in[4];
    a.lq2 = (const float*)d_in[5]; a.lk2 = (const float*)d_in[6]; a.subln = (const float*)d_in[7]; a.relb = (const float*)d_in[8]; a.gnb = (const float*)d_in[9];
    a.gnc = (const float*)d_in[10]; a.w_out = (const float*)d_in[11]; a.g_post_mix = (const float*)d_in[12]; a.g_pre_mlp = (const float*)d_in[13];
    a.w_up = (const float*)d_in[14]; a.w_down = (const float*)d_in[15]; a.g_post_mlp = (const float*)d_in[16];
    a.out = (float*)d_out; a.ws = (unsigned char*)d_ws;
    for (int j = 0; j < 8; ++j) a.inv_freq[j] = powf(500000.0f, -(float)(2 * j) / 16.0f);
    for (int l = 0; l < 2; ++l) a.lam_init[l] = (float)(0.8 - 0.6 * exp(-0.3 * (double)l));
    a.pad = 0;
#if MK_SPLIT
    a.coop = 0;
    for (int ph = 0; ph < NPHASE; ++ph) { a.ph_lo = ph; a.ph_hi = ph + 1; hipLaunchKernelGGL(mk_fwd, dim3(grid_blocks), dim3(512), LDS_BYTES, stream, a); }
#else
    a.coop = 1; a.ph_lo = 0; a.ph_hi = NPHASE;
    void* args[] = {&a};
    hipError_t e = hipLaunchCooperativeKernel((const void*)mk_fwd, dim3(grid_blocks), dim3(512), args, LDS_BYTES, stream);
    if (e != hipSuccess) fprintf(stderr, "cooperative launch failed: %s (grid %d)\n", hipGetErrorString(e), grid_blocks);
#endif
}
```
